# Optimizing an MI355X kernel written in HIP

```python
import math
import jax
import jax.numpy as jnp
from jax import lax
import numpy as np


D_MODEL = 1024
BATCH = 8
SEQ = 4096
DEPTH = 4
DEC_BATCH = 4
DEC_SEQ = 4096
PAST_LEN = 128

N_EVEN = (DEPTH + 1) // 2
N_ODD = DEPTH // 2

HY_WIDTH = D_MODEL
HY_EMB = 33
HY_FILTER_HIDDEN = 64
HY_SHORT_K = 3
HY_SHORT_DECAY_PCT = 0.3
HY_LONG_DECAY_PCT = 1.5
HY_DECAY_TARGET = 1e-2

SSD_WIDTH = D_MODEL
SSD_HEAD_DIM = 64
SSD_HEADS = SSD_WIDTH // SSD_HEAD_DIM
SSD_GROUPS = 4
SSD_STATE = 128
SSD_CONV_K = 4
SSD_CHUNK = 128
SSD_XBC = SSD_WIDTH + 2 * SSD_GROUPS * SSD_STATE

LRU_WIDTH = 2 * D_MODEL
LRU_HEADS = 16
LRU_BLOCK = LRU_WIDTH // LRU_HEADS
LRU_CONV_K = 4
LRU_C = 8.0

EVEN_IN = 4 * HY_WIDTH + SSD_WIDTH + SSD_XBC + 2 * SSD_HEADS
EVEN_MIX = HY_WIDTH + SSD_WIDTH
ODD_IN = 2 * LRU_WIDTH

kernel_name = 'hybrid_hyena_ssd_rglru_adaln_encoder'


def rms_norm(x, g, eps=1e-6):
    xf = x.astype(jnp.float32)
    y = xf * lax.rsqrt(jnp.mean(xf * xf, axis=-1, keepdims=True) + eps)
    return (y * g.astype(jnp.float32)).astype(x.dtype)


def dw_conv_centred(x, w, b):
    K = w.shape[0]
    L = x.shape[1]
    left = K // 2
    xp = jnp.pad(x, ((0, 0), (left, K - 1 - left), (0, 0)))
    return b + sum(xp[:, k:k + L] * w[k] for k in range(K))


def hyena_filter(L, w1, b1, w2, b2, w3, freq):
    f32 = jnp.float32
    pos = jnp.arange(L, dtype=f32)[:, None]
    t = pos / max(L - 1, 1)
    bands = (HY_EMB - 1) // 2
    f = jnp.linspace(1e-4, bands - 1, bands, dtype=f32)[None, :]
    ang = f * pos * (2.0 * math.pi / L)
    z = jnp.concatenate([t, jnp.cos(ang), -jnp.sin(ang)], axis=-1)
    fr = freq.astype(f32)
    h = jnp.sin(fr * (z @ w1.astype(f32) + b1.astype(f32)))
    h = jnp.sin(fr * (h @ w2.astype(f32) + b2.astype(f32)))
    h = h @ w3.astype(f32)
    deltas = jnp.abs(jnp.linspace(math.log(HY_DECAY_TARGET) / HY_LONG_DECAY_PCT,
                                  math.log(HY_DECAY_TARGET) / HY_SHORT_DECAY_PCT,
                                  HY_WIDTH, dtype=f32))
    window = jnp.exp(-t * deltas)
    h_fwd = h[:, :HY_WIDTH] * window
    h_bwd = h[:, HY_WIDTH:] * window
    filt = jnp.concatenate([h_fwd, jnp.zeros((1, HY_WIDTH), f32), h_bwd[:0:-1]], axis=0)
    return filt / jnp.sum(jnp.abs(filt), axis=0, keepdims=True)


def hyena_branch(u, conv_w, conv_b, fw1, fb1, fw2, fb2, fw3, freq, bias):
    L = u.shape[1]
    uc = dw_conv_centred(u, conv_w, conv_b)
    x0, x1, v = jnp.split(uc, 3, axis=-1)
    filt = hyena_filter(L, fw1, fb1, fw2, fb2, fw3, freq)
    vf = (v * x1).astype(jnp.float32)
    n = 2 * L
    y = jnp.fft.irfft(jnp.fft.rfft(vf, n=n, axis=1) * jnp.fft.rfft(filt, n=n, axis=0)[None],
                      n=n, axis=1)[:, :L]
    y = y + vf * bias.astype(jnp.float32)
    return x0 * y.astype(u.dtype)


def ssd_scan(x, dt, a, bm, cm):
    b, L = x.shape[0], x.shape[1]
    c, q = L // SSD_CHUNK, SSD_CHUNK
    G, R, P, N = SSD_GROUPS, SSD_HEADS // SSD_GROUPS, SSD_HEAD_DIM, SSD_STATE
    xs = (x * dt[..., None]).reshape(b, c, q, G, R, P)
    la = (dt * a).reshape(b, c, q, G, R)
    bc = bm.reshape(b, c, q, G, N)
    cc = cm.reshape(b, c, q, G, N)
    a_cum = jnp.cumsum(la, axis=2)
    diff = a_cum[:, :, :, None] - a_cum[:, :, None, :]
    mask = jnp.tril(jnp.ones((q, q), dtype=bool))[:, :, None, None]
    seg = jnp.exp(jnp.where(mask, diff, -jnp.inf))
    cb = jnp.einsum('bclgn,bcsgn->bclsg', cc, bc)
    y_diag = jnp.einsum('bclsgr,bcsgrp->bclgrp', cb[..., None] * seg, xs)
    decay_states = jnp.exp(a_cum[:, :, -1:] - a_cum)
    states = jnp.einsum('bclgn,bclgrp->bcgrpn', bc, decay_states[..., None] * xs)
    chunk_decay = jnp.exp(a_cum[:, :, -1])

    def step(h, inp):
        s, d = inp
        return h * d[..., None, None] + s, h

    h0 = jnp.zeros((b, G, R, P, N), x.dtype)
    _, prev = lax.scan(step, h0, (jnp.moveaxis(states, 1, 0), jnp.moveaxis(chunk_decay, 1, 0)))
    prev = jnp.moveaxis(prev, 0, 1)
    y_off = jnp.einsum('bclgn,bcgrpn->bclgrp', cc, prev) * jnp.exp(a_cum)[..., None]
    return (y_diag + y_off).reshape(b, L, SSD_HEADS, P)


def ssd_branch(z, xbc, dt_raw, conv_w, conv_b, dt_bias, a_log, d_skip, norm_g):
    f32 = jnp.float32
    b, L, _ = z.shape
    xbc = jax.nn.silu(dw_conv_centred(xbc, conv_w, conv_b)).astype(f32)
    xs, bm, cm = jnp.split(xbc, [SSD_WIDTH, SSD_WIDTH + SSD_GROUPS * SSD_STATE], axis=-1)
    xs = xs.reshape(b, L, SSD_HEADS, SSD_HEAD_DIM)
    bm = bm.reshape(b, L, SSD_GROUPS, SSD_STATE)
    cm = cm.reshape(b, L, SSD_GROUPS, SSD_STATE)
    dt = jax.nn.softplus(dt_raw.astype(f32).reshape(b, L, 2, SSD_HEADS) + dt_bias.astype(f32))
    a = -jnp.exp(a_log.astype(f32))
    fl = lambda t: jnp.flip(t, axis=1)
    y_fwd = ssd_scan(xs, dt[:, :, 0], a[0], bm, cm)
    y_bwd = fl(ssd_scan(fl(xs), fl(dt[:, :, 1]), a[1], fl(bm), fl(cm)))
    y = y_fwd + y_bwd + xs * d_skip.astype(f32)[:, None]
    y = y.reshape(b, L, SSD_WIDTH) * jax.nn.silu(z.astype(f32))
    yg = y.reshape(b, L, SSD_GROUPS, SSD_WIDTH // SSD_GROUPS)
    yg = yg * lax.rsqrt(jnp.mean(yg * yg, axis=-1, keepdims=True) + 1e-5)
    return (yg.reshape(b, L, SSD_WIDTH) * norm_g.astype(f32)).astype(z.dtype)


def rg_lru(x, w_a, b_a, w_x, b_x, lam):
    f32 = jnp.float32
    b, L, W = x.shape
    xh = x.reshape(b, L, LRU_HEADS, LRU_BLOCK)
    r = jax.nn.sigmoid(jnp.einsum('blhi,hij->blhj', xh, w_a.astype(f32)).reshape(b, L, W) + b_a.astype(f32))
    i = jax.nn.sigmoid(jnp.einsum('blhi,hij->blhj', xh, w_x.astype(f32)).reshape(b, L, W) + b_x.astype(f32))
    log_a = LRU_C * r * jax.nn.log_sigmoid(lam.astype(f32))
    a = jnp.exp(log_a)
    u = x * i * jnp.sqrt(-jnp.expm1(2.0 * log_a))

    def step(h, inp):
        a_t, u_t = inp
        h = a_t * h + u_t
        return h, h

    _, hs = lax.scan(step, jnp.zeros((b, W), f32), (jnp.swapaxes(a, 0, 1), jnp.swapaxes(u, 0, 1)))
    return jnp.swapaxes(hs, 0, 1)


def even_mixer(h, p, j):
    u = h @ p['ev_w_in'][j]
    o1 = 3 * HY_WIDTH
    o2 = 4 * HY_WIDTH
    o3 = o2 + SSD_WIDTH
    o4 = o3 + SSD_XBC
    hy_u, hy_gate, z, xbc, dt_raw = jnp.split(u, [o1, o2, o3, o4], axis=-1)
    y_a = hyena_branch(hy_u, p['hy_conv_w'][j], p['hy_conv_b'][j], p['hy_fw1'][j], p['hy_fb1'][j],
                       p['hy_fw2'][j], p['hy_fb2'][j], p['hy_fw3'][j], p['hy_freq'][j],
                       p['hy_bias'][j]) * jax.nn.silu(hy_gate)
    y_b = ssd_branch(z, xbc, dt_raw, p['ssd_conv_w'][j], p['ssd_conv_b'][j], p['ssd_dt_bias'][j],
                     p['ssd_A_log'][j], p['ssd_D'][j], p['ssd_norm_g'][j])
    return jnp.concatenate([y_a, y_b], axis=-1) @ p['ev_w_out'][j]


def odd_mixer(h, p, j):
    u = h @ p['od_w_in'][j]
    xb, gate = jnp.split(u, 2, axis=-1)
    xb = dw_conv_centred(xb, p['lru_conv_w'][j], p['lru_conv_b'][j]).astype(jnp.float32)
    y_fwd = rg_lru(xb, p['lru_w_a'][j, 0], p['lru_b_a'][j, 0], p['lru_w_x'][j, 0],
                   p['lru_b_x'][j, 0], p['lru_lam'][j, 0])
    y_bwd = jnp.flip(rg_lru(jnp.flip(xb, axis=1), p['lru_w_a'][j, 1], p['lru_b_a'][j, 1],
                            p['lru_w_x'][j, 1], p['lru_b_x'][j, 1], p['lru_lam'][j, 1]), axis=1)
    y = (y_fwd + y_bwd).astype(h.dtype) * jax.nn.silu(gate)
    return y @ p['od_w_out'][j]


def trunk(x, c, p):
    cs = jax.nn.silu(c)
    for i in range(DEPTH):
        shift, scale, gate = jnp.split(cs @ p['mod_w'][i] + p['mod_b'][i], 3, axis=-1)
        hn = rms_norm(x, p['norm_g'][i]) * (1.0 + scale[:, None]) + shift[:, None]
        out = even_mixer(hn, p, i // 2) if i % 2 == 0 else odd_mixer(hn, p, i // 2)
        x = x + gate[:, None] * out
    return rms_norm(x, p['final_g'])


def setup_inputs(seed: int = 0) -> dict:
    key = jax.random.key(seed)
    ks = iter(list(jax.random.split(key, 48)))
    f32 = jnp.float32

    def nrm(shape, scale):
        return scale * jax.random.normal(next(ks), shape, f32)

    def unif(shape, lo, hi):
        return jax.random.uniform(next(ks), shape, f32, minval=lo, maxval=hi)

    D = D_MODEL
    x_prompt = nrm((BATCH, SEQ, D), 1.0)
    x_sample = nrm((DEC_BATCH, DEC_SEQ, D), 1.0)
    c_prompt = nrm((BATCH, D), 1.0)
    c_sample = nrm((DEC_BATCH, D), 1.0)
    mod_w = nrm((DEPTH, D, 3 * D), 0.5 * D ** -0.5)
    mod_b = nrm((DEPTH, 3 * D), 0.02)
    norm_g = 1.0 + nrm((DEPTH, D), 0.02)
    final_g = 1.0 + nrm((D,), 0.02)
    ev_w_in = nrm((N_EVEN, D, EVEN_IN), D ** -0.5)
    ev_w_out = nrm((N_EVEN, EVEN_MIX, D), EVEN_MIX ** -0.5)
    hy_conv_w = nrm((N_EVEN, HY_SHORT_K, 3 * HY_WIDTH), HY_SHORT_K ** -0.5)
    hy_conv_b = nrm((N_EVEN, 3 * HY_WIDTH), 0.02)
    hy_fw1 = nrm((N_EVEN, HY_EMB, HY_FILTER_HIDDEN), HY_EMB ** -0.5)
    hy_fb1 = nrm((N_EVEN, HY_FILTER_HIDDEN), 0.02)
    hy_fw2 = nrm((N_EVEN, HY_FILTER_HIDDEN, HY_FILTER_HIDDEN), HY_FILTER_HIDDEN ** -0.5)
    hy_fb2 = nrm((N_EVEN, HY_FILTER_HIDDEN), 0.02)
    hy_fw3 = nrm((N_EVEN, HY_FILTER_HIDDEN, 2 * HY_WIDTH), HY_FILTER_HIDDEN ** -0.5)
    hy_freq = 1.0 + nrm((N_EVEN, HY_FILTER_HIDDEN), 0.1)
    hy_bias = nrm((N_EVEN, HY_WIDTH), 0.1)
    ssd_conv_w = nrm((N_EVEN, SSD_CONV_K, SSD_XBC), SSD_CONV_K ** -0.5)
    ssd_conv_b = nrm((N_EVEN, SSD_XBC), 0.02)
    dt0 = jnp.exp(unif((N_EVEN, 2, SSD_HEADS), math.log(1e-3), math.log(1e-1)))
    ssd_dt_bias = dt0 + jnp.log(-jnp.expm1(-dt0))
    ssd_A_log = jnp.log(unif((N_EVEN, 2, SSD_HEADS), 1.0, 16.0))
    ssd_D = 1.0 + nrm((N_EVEN, SSD_HEADS), 0.1)
    ssd_norm_g = 1.0 + nrm((N_EVEN, SSD_WIDTH), 0.02)
    od_w_in = nrm((N_ODD, D, ODD_IN), D ** -0.5)
    od_w_out = nrm((N_ODD, LRU_WIDTH, D), LRU_WIDTH ** -0.5)
    lru_conv_w = nrm((N_ODD, LRU_CONV_K, LRU_WIDTH), LRU_CONV_K ** -0.5)
    lru_conv_b = nrm((N_ODD, LRU_WIDTH), 0.02)
    lru_w_a = nrm((N_ODD, 2, LRU_HEADS, LRU_BLOCK, LRU_BLOCK), LRU_BLOCK ** -0.5)
    lru_b_a = nrm((N_ODD, 2, LRU_WIDTH), 0.02)
    lru_w_x = nrm((N_ODD, 2, LRU_HEADS, LRU_BLOCK, LRU_BLOCK), LRU_BLOCK ** -0.5)
    lru_b_x = nrm((N_ODD, 2, LRU_WIDTH), 0.02)
    s = unif((N_ODD, 2, LRU_WIDTH), 0.9, 0.999) ** (1.0 / LRU_C)
    lru_lam = jnp.log(s) - jnp.log1p(-s)
    return {'x_prompt': x_prompt, 'x_sample': x_sample, 'c_prompt': c_prompt, 'c_sample': c_sample,
            'mod_w': mod_w, 'mod_b': mod_b, 'norm_g': norm_g, 'final_g': final_g,
            'ev_w_in': ev_w_in, 'ev_w_out': ev_w_out,
            'hy_conv_w': hy_conv_w, 'hy_conv_b': hy_conv_b, 'hy_fw1': hy_fw1, 'hy_fb1': hy_fb1,
            'hy_fw2': hy_fw2, 'hy_fb2': hy_fb2, 'hy_fw3': hy_fw3, 'hy_freq': hy_freq, 'hy_bias': hy_bias,
            'ssd_conv_w': ssd_conv_w, 'ssd_conv_b': ssd_conv_b, 'ssd_dt_bias': ssd_dt_bias,
            'ssd_A_log': ssd_A_log, 'ssd_D': ssd_D, 'ssd_norm_g': ssd_norm_g,
            'od_w_in': od_w_in, 'od_w_out': od_w_out, 'lru_conv_w': lru_conv_w, 'lru_conv_b': lru_conv_b,
            'lru_w_a': lru_w_a, 'lru_b_a': lru_b_a, 'lru_w_x': lru_w_x, 'lru_b_x': lru_b_x,
            'lru_lam': lru_lam}


def reference(x_prompt, x_sample, c_prompt, c_sample, mod_w, mod_b, norm_g, final_g,
              ev_w_in, ev_w_out, hy_conv_w, hy_conv_b, hy_fw1, hy_fb1, hy_fw2, hy_fb2, hy_fw3,
              hy_freq, hy_bias, ssd_conv_w, ssd_conv_b, ssd_dt_bias, ssd_A_log, ssd_D, ssd_norm_g,
              od_w_in, od_w_out, lru_conv_w, lru_conv_b, lru_w_a, lru_b_a, lru_w_x, lru_b_x, lru_lam):
    p = {'mod_w': mod_w, 'mod_b': mod_b, 'norm_g': norm_g, 'final_g': final_g,
         'ev_w_in': ev_w_in, 'ev_w_out': ev_w_out,
         'hy_conv_w': hy_conv_w, 'hy_conv_b': hy_conv_b, 'hy_fw1': hy_fw1, 'hy_fb1': hy_fb1,
         'hy_fw2': hy_fw2, 'hy_fb2': hy_fb2, 'hy_fw3': hy_fw3, 'hy_freq': hy_freq, 'hy_bias': hy_bias,
         'ssd_conv_w': ssd_conv_w, 'ssd_conv_b': ssd_conv_b, 'ssd_dt_bias': ssd_dt_bias,
         'ssd_A_log': ssd_A_log, 'ssd_D': ssd_D, 'ssd_norm_g': ssd_norm_g,
         'od_w_in': od_w_in, 'od_w_out': od_w_out, 'lru_conv_w': lru_conv_w, 'lru_conv_b': lru_conv_b,
         'lru_w_a': lru_w_a, 'lru_b_a': lru_b_a, 'lru_w_x': lru_w_x, 'lru_b_x': lru_b_x,
         'lru_lam': lru_lam}
    y_prompt = trunk(x_prompt, c_prompt, p)
    y_sample = trunk(x_sample, c_sample, p)
    return (y_prompt, y_sample)
```

```cpp
#include <hip/hip_runtime.h>
#include <hip/hip_cooperative_groups.h>
#include <hip/hip_fp16.h>
#include <cstdio>
namespace cg = cooperative_groups;

typedef unsigned short u16;
using bf16x8 = __attribute__((ext_vector_type(8))) short;
using f32x4 = __attribute__((ext_vector_type(4))) float;
using u32x4 = __attribute__((ext_vector_type(4))) unsigned int;
#define DEVI __device__ __forceinline__

constexpr int L = 4096, D = 1024, NSEQ = 12, RS = 4, RT = RS * L, NROUND = 3;
constexpr int EV_IN = 7200, EV_NPAD = 7296;
constexpr int NTHR = 256;
constexpr int SMEM_BYTES = 74752;

constexpr size_t OFF_WT = 0;
constexpr size_t SZ_WT = (size_t)EV_NPAD * 1024 * 2 + (size_t)1024 * 2048 * 2;
constexpr size_t WTO_EVOUT = (size_t)EV_NPAD * 1024;
constexpr size_t WTO_ODOUT = (size_t)4096 * 1024;
constexpr size_t WTO_LRU = WTO_ODOUT + (size_t)1024 * 2048;
constexpr size_t OFF_MOD = OFF_WT + SZ_WT;
constexpr size_t SZ_MOD = (size_t)4 * 12 * 3072 * 4;
constexpr size_t OFF_TW = OFF_MOD + SZ_MOD;
constexpr size_t SZ_TW = 8192 * 8;
constexpr size_t OFF_H2 = OFF_TW + SZ_TW;
constexpr size_t SZ_H2 = (size_t)2 * 4096 * 64 * 4;
constexpr size_t OFF_DT = OFF_H2 + SZ_H2;
constexpr size_t SZ_DT = (size_t)RT * 32 * 4;
constexpr size_t OFF_HSPEC = OFF_DT + SZ_DT;
constexpr size_t SZ_HSPEC = (size_t)1024 * 8192 * 4;
constexpr size_t OFF_HN = OFF_HSPEC + SZ_HSPEC;
constexpr size_t SZ_HN = (size_t)RT * 1024 * 2;
constexpr size_t OFF_U = OFF_HN + SZ_HN;
constexpr size_t SZ_U = (size_t)RT * 4096 * 2;
constexpr size_t OFF_U2 = OFF_U + SZ_U;
constexpr size_t SZ_U2 = (size_t)RT * 4096 * 2;
constexpr size_t OFF_XACT = OFF_U2 + SZ_U2;
constexpr size_t SZ_XACT = (size_t)RT * 2048 * 2;
constexpr size_t OFF_MIX = OFF_XACT + SZ_XACT;
constexpr size_t SZ_MIX = (size_t)RT * 2048 * 2;
constexpr size_t OFF_BAR = OFF_MIX + SZ_MIX;
constexpr size_t SZ_BAR = (size_t)3456 * 4;
constexpr size_t WS_NEED = OFF_BAR + 16384;
constexpr size_t OFF_YF = OFF_HN;
constexpr size_t OFF_USSD = OFF_U2;
constexpr size_t OFF_YB = OFF_U2 + (size_t)RT * 3072 * 2;
constexpr size_t OFF_HF = OFF_U2;
constexpr size_t OFF_HB = OFF_U2 + (size_t)RT * 2048 * 2;

#define XB_TMO      128
#define XB_XCNT(j)  (256  + 64 * (j))
#define XB_XSUB(j)  (1280 + 64 * (j))
#define XB_XGEN(j)  (2304 + 64 * (j))
#define XB_TOP      3328
#define XB_TOPGEN   3392
#define XCD_BAR_WORDS 3456
#define XB_SPIN_CAP (1u << 22)
#define LAS __attribute__((address_space(3)))

__device__ __forceinline__ unsigned xb_ld(unsigned* p)              { return __hip_atomic_load(p, __ATOMIC_RELAXED, __HIP_MEMORY_SCOPE_AGENT); }
__device__ __forceinline__ unsigned xb_add(unsigned* p, unsigned v) { return __hip_atomic_fetch_add(p, v, __ATOMIC_RELAXED, __HIP_MEMORY_SCOPE_AGENT); }
__device__ __forceinline__ unsigned xb_xcc_id() { return (unsigned)__builtin_amdgcn_s_getreg((3 << 11) | 20) & 0xFu; }
#define XB_SPIN(cond, bar) do { unsigned _sp = 0; while (cond) { __builtin_amdgcn_s_sleep(1); \
    if ((++_sp & 255u) == 0u) { if (xb_ld(&(bar)[XB_TMO])) break; if (_sp > XB_SPIN_CAP) { atomicAdd(&(bar)[XB_TMO], 1u); break; } } } } while (0)

struct XcdBarrier {
    unsigned* bar; unsigned x;
    volatile LAS unsigned* st;
};

__device__ __forceinline__ XcdBarrier xcd_barrier_post(unsigned* bar, volatile LAS unsigned* st) {
    XcdBarrier b; b.bar = bar; b.x = xb_xcc_id(); b.st = st;
    if (threadIdx.x == 0) (void)xb_add(&bar[XB_XCNT(b.x)], 1u);
    return b;
}
__device__ __forceinline__ void xcd_barrier_complete(unsigned* bar, unsigned x, unsigned& nloc, unsigned& nx) {
    const unsigned G = gridDim.x * gridDim.y * gridDim.z;
    unsigned sum, cnt, mine, sp = 0u;
    for (;;) {
        sum = 0u; cnt = 0u; mine = 0u;
#pragma unroll
        for (unsigned j = 0; j < 16; ++j) { const unsigned c = xb_ld(&bar[XB_XCNT(j)]); sum += c; cnt += (c > 0u) ? 1u : 0u; mine = (j == x) ? c : mine; }
        if (sum == G) break;
        __builtin_amdgcn_s_sleep(1);
        if ((++sp & 255u) == 0u) { if (xb_ld(&bar[XB_TMO])) break; if (sp > XB_SPIN_CAP) { atomicAdd(&bar[XB_TMO], 1u); break; } }
    }
    nloc = mine > 0u ? mine : 1u; nx = cnt > 0u ? cnt : 1u;
}

__device__ __forceinline__ void xcd_barrier(const XcdBarrier& b) {
    asm volatile("s_waitcnt vmcnt(0)" ::: "memory");
    __syncthreads();
    if (threadIdx.x == 0) {
        unsigned* bar = b.bar;
        __builtin_amdgcn_s_waitcnt(0);
        unsigned nloc = b.st[0], nx = b.st[1];
        if (nloc == 0u) { xcd_barrier_complete(bar, b.x, nloc, nx); b.st[0] = nloc; b.st[1] = nx; }
        const unsigned old = xb_add(&bar[XB_XSUB(b.x)], 1u);
        const unsigned gen = old / nloc;
        if (old + 1u == (gen + 1u) * nloc) {
            __builtin_amdgcn_fence(__ATOMIC_RELEASE, "agent");
            asm volatile("s_waitcnt vmcnt(0)" ::: "memory");
            const unsigned og = xb_add(&bar[XB_TOP], 1u);
            const unsigned tg = og / nx;
            if (og + 1u == (tg + 1u) * nx) xb_add(&bar[XB_TOPGEN], 1u);
            else XB_SPIN(xb_ld(&bar[XB_TOPGEN]) == tg, bar);
            __builtin_amdgcn_fence(__ATOMIC_ACQUIRE, "agent");
            xb_add(&bar[XB_XGEN(b.x)], 1u);
            asm volatile("s_waitcnt vmcnt(0)" ::: "memory");
        } else {
            XB_SPIN(xb_ld(&bar[XB_XGEN(b.x)]) == gen, bar);
            __builtin_amdgcn_fence(__ATOMIC_ACQUIRE, "agent");
            asm volatile("s_waitcnt vmcnt(0)" ::: "memory");
        }
    }
    __syncthreads();
}


struct Params {
  const float *x_prompt, *x_sample, *c_prompt, *c_sample, *mod_w, *mod_b, *norm_g, *final_g;
  const float *ev_w_in, *ev_w_out, *hy_conv_w, *hy_conv_b, *hy_fw1, *hy_fb1, *hy_fw2, *hy_fb2, *hy_fw3, *hy_freq, *hy_bias;
  const float *ssd_conv_w, *ssd_conv_b, *ssd_dt_bias, *ssd_A_log, *ssd_D, *ssd_norm_g;
  const float *od_w_in, *od_w_out, *lru_conv_w, *lru_conv_b, *lru_w_a, *lru_b_a, *lru_w_x, *lru_b_x, *lru_lam;
  float* out;
  char* ws;
};

DEVI unsigned pack2(float a, float b) { unsigned r; asm("v_cvt_pk_bf16_f32 %0, %1, %2" : "=v"(r) : "v"(a), "v"(b)); return r; }
DEVI u16 f2bf(float f) { return (u16)(pack2(f, 0.f) & 0xffffu); }
DEVI float bf2f(u16 h) { return __uint_as_float(((unsigned)h) << 16); }
DEVI float bflo(unsigned w) { return __uint_as_float(w << 16); }
DEVI float bfhi(unsigned w) { return __uint_as_float(w & 0xffff0000u); }
DEVI void unpack8v(u32x4 v, float (&f)[8]) {
  f[0] = bflo(v[0]); f[1] = bfhi(v[0]); f[2] = bflo(v[1]); f[3] = bfhi(v[1]);
  f[4] = bflo(v[2]); f[5] = bfhi(v[2]); f[6] = bflo(v[3]); f[7] = bfhi(v[3]);
}
DEVI void unpack8(uint4 v, float (&f)[8]) {
  f[0] = bflo(v.x); f[1] = bfhi(v.x); f[2] = bflo(v.y); f[3] = bfhi(v.y);
  f[4] = bflo(v.z); f[5] = bfhi(v.z); f[6] = bflo(v.w); f[7] = bfhi(v.w);
}
DEVI uint4 pack8(const float (&f)[8]) {
  uint4 v; v.x = pack2(f[0], f[1]); v.y = pack2(f[2], f[3]); v.z = pack2(f[4], f[5]); v.w = pack2(f[6], f[7]); return v;
}
DEVI float rcp_f(float x) { return __builtin_amdgcn_rcpf(x); }
DEVI float fexp(float x) { return __builtin_amdgcn_exp2f(x * 1.4426950408889634f); }
DEVI float silu_f(float x) { return x * rcp_f(1.f + fexp(-x)); }
DEVI float sigmoid_f(float x) { return rcp_f(1.f + fexp(-x)); }
DEVI float softplus_f(float x) {
  float e = fexp(fminf(x, 30.f));
  float small = e * (1.f - e * (0.5f - e * 0.33333334f));
  float big = __builtin_amdgcn_logf(1.f + e) * 0.6931471805599453f;
  float r = (e < 0.01f) ? small : big;
  return x > 20.f ? x : r;
}
DEVI float sin_f(float x) { return sinpif(x * 0.3183098861837907f); }
DEVI int swz256(int row, int c16) { return row * 256 + ((c16 ^ (row & 15)) << 4); }
DEVI int swz128(int row, int c16) { return row * 128 + ((c16 ^ ((row >> 1) & 7)) << 4); }
DEVI bf16x8 ldsfrag(const char* base, int off) { return *(const bf16x8*)(base + off); }
DEVI f32x4 mfma16(bf16x8 a, bf16x8 b, f32x4 c) { return __builtin_amdgcn_mfma_f32_16x16x32_bf16(a, b, c, 0, 0, 0); }
DEVI float wave_sum(float v) {
#pragma unroll
  for (int o = 32; o >= 1; o >>= 1) v += __shfl_xor(v, o);
  return v;
}
DEVI void lds_barrier() { asm volatile("s_waitcnt lgkmcnt(0)\n\ts_barrier" ::: "memory"); }
DEVI int tid() { int t = threadIdx.x; asm volatile("" : "+v"(t)); return t; }
DEVI int bid() { int b = blockIdx.x; asm volatile("" : "+s"(b)); return b; }
DEVI int vblock() {
  int nb = gridDim.x, b = bid();
  return (nb & 7) ? b : ((b & 7) * (nb >> 3) + (b >> 3));
}
DEVI const float* xsrc_ptr(const Params& p, int layer, int sg) {
  if (layer == 0) return sg < 8 ? p.x_prompt + (size_t)sg * L * D : p.x_sample + (size_t)(sg - 8) * L * D;
  return p.out + (size_t)sg * L * D;
}

DEVI void tconv_tile(const float* src, int K, int N, u16* dst, int kt, int nt, float* lds) {
  int t = tid();
#pragma unroll 4
  for (int i = 0; i < 16; ++i) {
    int e = t + 256 * i; int kk = e >> 6, nn = e & 63; int n = nt * 64 + nn;
    float v = (n < N) ? src[(size_t)(kt * 64 + kk) * N + n] : 0.f;
    lds[nn * 65 + kk] = v;
  }
  __syncthreads();
#pragma unroll
  for (int i = 0; i < 2; ++i) {
    int e = t + 256 * i; int nn = e >> 3, c8 = e & 7;
    float f[8];
#pragma unroll
    for (int k = 0; k < 8; ++k) f[k] = lds[nn * 65 + c8 * 8 + k];
    *(uint4*)(dst + (size_t)(nt * 64 + nn) * K + kt * 64 + c8 * 8) = pack8(f);
  }
  __syncthreads();
}

DEVI void mod_tile(const Params& p, int tile, char* lds) {
  int layer = tile / 48, nchunk = tile % 48;
  int t = tid();
  float* cs = (float*)lds;
  for (int e = t; e < 12288; e += 256) {
    int b = e >> 10, k = e & 1023;
    float c = b < 8 ? p.c_prompt[b * 1024 + k] : p.c_sample[(b - 8) * 1024 + k];
    cs[e] = silu_f(c);
  }
  __syncthreads();
  int nn = t & 63, ks = t >> 6;
  int n = nchunk * 64 + nn;
  float acc[12];
#pragma unroll
  for (int b = 0; b < 12; ++b) acc[b] = 0.f;
  const float* w = p.mod_w + (size_t)layer * 1024 * 3072 + n;
  for (int k = ks * 256; k < ks * 256 + 256; ++k) {
    float wv = w[(size_t)k * 3072];
#pragma unroll
    for (int b = 0; b < 12; ++b) acc[b] += cs[b * 1024 + k] * wv;
  }
  float* red = cs + 12288;
#pragma unroll
  for (int b = 0; b < 12; ++b) red[(ks * 12 + b) * 64 + nn] = acc[b];
  __syncthreads();
  float* modp = (float*)(p.ws + OFF_MOD);
  for (int e = t; e < 768; e += 256) {
    int b = e >> 6, n2 = e & 63;
    float s = red[(0 * 12 + b) * 64 + n2] + red[(1 * 12 + b) * 64 + n2] + red[(2 * 12 + b) * 64 + n2] + red[(3 * 12 + b) * 64 + n2];
    modp[(size_t)(layer * 12 + b) * 3072 + nchunk * 64 + n2] = s + p.mod_b[layer * 3072 + nchunk * 64 + n2];
  }
  __syncthreads();
}

DEVI void h2_tile(const Params& p, int tile, char* lds) {
  int j = tile >> 10, pos0 = (tile & 1023) * 4;
  int t = tid();
  float* zs = (float*)lds;
  float* h1s = zs + 4 * 36;
  if (t < 4 * 33) {
    int pp = t / 33, e = t % 33; int pos = pos0 + pp;
    float val;
    if (e == 0) val = (float)pos / 4095.f;
    else {
      int b = (e - 1) & 15;
      float f = 1e-4f + (float)b * ((15.f - 1e-4f) / 15.f);
      float rev = f * (float)pos * (1.f / 4096.f);
      rev -= floorf(rev);
      float s, c; sincospif(2.f * rev, &s, &c);
      val = (e <= 16) ? c : -s;
    }
    zs[pp * 36 + e] = val;
  }
  __syncthreads();
  int pp = t >> 6, jj = t & 63;
  float fr = p.hy_freq[j * 64 + jj];
  float a = p.hy_fb1[j * 64 + jj];
  for (int e = 0; e < 33; ++e) a += zs[pp * 36 + e] * p.hy_fw1[(j * 33 + e) * 64 + jj];
  h1s[pp * 64 + jj] = sin_f(fr * a);
  __syncthreads();
  a = p.hy_fb2[j * 64 + jj];
  for (int i = 0; i < 64; ++i) a += h1s[pp * 64 + i] * p.hy_fw2[(j * 64 + i) * 64 + jj];
  float* H2 = (float*)(p.ws + OFF_H2);
  H2[((size_t)j * 4096 + pos0 + pp) * 64 + jj] = sin_f(fr * a);
  __syncthreads();
}

constexpr int PREP_T_MOD = 192;
constexpr int PREP_T_TW = 32;
constexpr int PREP_T_H2 = 2048;
constexpr int PREP_TOTAL = PREP_T_MOD + PREP_T_TW + PREP_T_H2;

DEVI void prep_phase(const Params& p, char* lds) {
  for (int tile = bid(); tile < PREP_TOTAL; tile += gridDim.x) {
    int t = tile;
    if (t < PREP_T_MOD) { mod_tile(p, t, lds); continue; }
    t -= PREP_T_MOD;
    if (t < PREP_T_TW) {
      int k = t * 256 + tid();
      int hh = (k == 0) ? 1 : (1 << (31 - __clz(k)));
      int jj = (k == 0) ? 0 : (k - hh);
      float s, c; sincospif((float)jj / (float)hh, &s, &c);
      ((float2*)(p.ws + OFF_TW))[k] = make_float2(c, -s);
      continue;
    }
    t -= PREP_T_TW;
    h2_tile(p, t, lds);
  }
}

constexpr int WT_T_EVIN = 16 * 114, WT_T_EVOUT = 32 * 16, WT_T_EVEN = WT_T_EVIN + WT_T_EVOUT;
constexpr int WT_T_ODIN = 16 * 64, WT_T_ODOUT = 32 * 16, WT_T_LRU = 64 * 4, WT_T_ODD = WT_T_ODIN + WT_T_ODOUT + WT_T_LRU;
DEVI void wt_tile(const Params& p, int layer, int t, char* lds) {
  int j = layer >> 1;
  u16* WT = (u16*)(p.ws + OFF_WT);
  if (!(layer & 1)) {
    if (t < WT_T_EVIN) { tconv_tile(p.ev_w_in + (size_t)j * 1024 * EV_IN, 1024, EV_IN, WT, t % 16, t / 16, (float*)lds); return; }
    t -= WT_T_EVIN;
    tconv_tile(p.ev_w_out + (size_t)j * 2048 * 1024, 2048, 1024, WT + WTO_EVOUT, t % 32, t / 32, (float*)lds);
  } else {
    if (t < WT_T_ODIN) { tconv_tile(p.od_w_in + (size_t)j * 1024 * 4096, 1024, 4096, WT, t % 16, t / 16, (float*)lds); return; }
    t -= WT_T_ODIN;
    if (t < WT_T_ODOUT) { tconv_tile(p.od_w_out + (size_t)j * 2048 * 1024, 2048, 1024, WT + WTO_ODOUT, t % 32, t / 32, (float*)lds); return; }
    t -= WT_T_ODOUT;
    int m = t >> 2, sub = t & 3;
    int dir = m >> 5, gate = (m >> 4) & 1, h = m & 15;
    const float* src = (gate ? p.lru_w_x : p.lru_w_a) + ((size_t)((j * 2 + dir) * 16 + h)) * 16384;
    tconv_tile(src, 128, 128, WT + WTO_LRU + (size_t)m * 16384, sub & 1, sub >> 1, (float*)lds);
  }
}

DEVI int zi(int n) { return n + (n >> 4); }
template <bool INV>
DEVI void bfly_store(float2* z, int i0, int i1, float ax, float ay, float cx, float cy, float wx, float wy) {
  if (!INV) {
    float dx = ax - cx, dy = ay - cy;
    z[i0] = make_float2(ax + cx, ay + cy);
    z[i1] = make_float2(dx * wx - dy * wy, dx * wy + dy * wx);
  } else {
    float px = cx * wx + cy * wy, py = cy * wx - cx * wy;
    z[i0] = make_float2(ax + px, ay + py);
    z[i1] = make_float2(ax - px, ay - py);
  }
}
constexpr float W32C[16] = {1.0000000000f, 0.9807852804f, 0.9238795325f, 0.8314696123f, 0.7071067812f, 0.5555702330f, 0.3826834324f, 0.1950903220f, 0.0000000000f, -0.1950903220f, -0.3826834324f, -0.5555702330f, -0.7071067812f, -0.8314696123f, -0.9238795325f, -0.9807852804f};
constexpr float W32S[16] = {0.0000000000f, 0.1950903220f, 0.3826834324f, 0.5555702330f, 0.7071067812f, 0.8314696123f, 0.9238795325f, 0.9807852804f, 1.0000000000f, 0.9807852804f, 0.9238795325f, 0.8314696123f, 0.7071067812f, 0.5555702330f, 0.3826834324f, 0.1950903220f};
template <int H, bool INV>
DEVI void fft_stage_big(float2* z, float bwx, float bwy, int t) {
  const int zb = t + (t >> 4);
  constexpr int hz = H + (H >> 4);
#pragma unroll
  for (int hb = 0; hb < 2; ++hb) {
    float ax[8], ay[8], cx[8], cy[8];
#pragma unroll
    for (int k = 0; k < 8; ++k) {
      const int K = hb * 8 + k;
      const int C1 = (256 * K) & (H - 1), Ci = 512 * K - C1;
      const int i0 = zb + Ci + (Ci >> 4);
      float2 a = z[i0], c = z[i0 + hz];
      ax[k] = a.x; ay[k] = a.y; cx[k] = c.x; cy[k] = c.y;
    }
#pragma unroll
    for (int k = 0; k < 8; ++k) {
      const int K = hb * 8 + k;
      const int C1 = (256 * K) & (H - 1), Ci = 512 * K - C1;
      const int i0 = zb + Ci + (Ci >> 4);
      const int m = (C1 * 16) / H;
      const float rc = W32C[m], rs = W32S[m];
      float wx = bwx * rc + bwy * rs, wy = bwy * rc - bwx * rs;
      bfly_store<INV>(z, i0, i0 + hz, ax[k], ay[k], cx[k], cy[k], wx, wy);
    }
  }
  __syncthreads();
}
template <bool INV>
DEVI void fft_stage_small(float2* z, int h, float wx, float wy, int t) {
  const int jj = t & (h - 1);
  const int u = 2 * t - jj;
  float2* z0 = z + (u + (u >> 4));
  float2* z1 = z0 + (h + (h >= 16 ? (h >> 4) : 0));
#pragma unroll
  for (int hb = 0; hb < 2; ++hb) {
    float ax[8], ay[8], cx[8], cy[8];
#pragma unroll
    for (int k = 0; k < 8; ++k) {
      const int K = hb * 8 + k;
      float2 a = z0[544 * K], c = z1[544 * K];
      ax[k] = a.x; ay[k] = a.y; cx[k] = c.x; cy[k] = c.y;
    }
#pragma unroll
    for (int k = 0; k < 8; ++k) {
      const int K = hb * 8 + k;
      if (!INV) {
        float dx = ax[k] - cx[k], dy = ay[k] - cy[k];
        z0[544 * K] = make_float2(ax[k] + cx[k], ay[k] + cy[k]);
        z1[544 * K] = make_float2(dx * wx - dy * wy, dx * wy + dy * wx);
      } else {
        float px = cx[k] * wx + cy[k] * wy, py = cy[k] * wx - cx[k] * wy;
        z0[544 * K] = make_float2(ax[k] + px, ay[k] + py);
        z1[544 * K] = make_float2(ax[k] - px, ay[k] - py);
      }
    }
  }
  __syncthreads();
}
template <bool INV>
DEVI void r4_bfly(float2& e0, float2& e1, float2& e2, float2& e3, float w1x, float w1y) {
  float w2x = w1x * w1x - w1y * w1y, w2y = 2.f * w1x * w1y;
  if (!INV) {
    float y0x = e0.x + e2.x, y0y = e0.y + e2.y;
    float dx = e0.x - e2.x, dy = e0.y - e2.y;
    float y2x = dx * w1x - dy * w1y, y2y = dx * w1y + dy * w1x;
    float y1x = e1.x + e3.x, y1y = e1.y + e3.y;
    float ex = e1.x - e3.x, ey = e1.y - e3.y;
    float tx = ex * w1x - ey * w1y, ty = ex * w1y + ey * w1x;
    float y3x = ty, y3y = -tx;
    e0 = make_float2(y0x + y1x, y0y + y1y);
    float fx = y0x - y1x, fy = y0y - y1y;
    e1 = make_float2(fx * w2x - fy * w2y, fx * w2y + fy * w2x);
    e2 = make_float2(y2x + y3x, y2y + y3y);
    float gx = y2x - y3x, gy = y2y - y3y;
    e3 = make_float2(gx * w2x - gy * w2y, gx * w2y + gy * w2x);
  } else {
    float p1x = e1.x * w2x + e1.y * w2y, p1y = e1.y * w2x - e1.x * w2y;
    float p3x = e3.x * w2x + e3.y * w2y, p3y = e3.y * w2x - e3.x * w2y;
    float y0x = e0.x + p1x, y0y = e0.y + p1y, y1x = e0.x - p1x, y1y = e0.y - p1y;
    float y2x = e2.x + p3x, y2y = e2.y + p3y, y3x = e2.x - p3x, y3y = e2.y - p3y;
    float q2x = y2x * w1x + y2y * w1y, q2y = y2y * w1x - y2x * w1y;
    float rx = y3x * w1x + y3y * w1y, ry = y3y * w1x - y3x * w1y;
    float q3x = -ry, q3y = rx;
    e0 = make_float2(y0x + q2x, y0y + q2y);
    e2 = make_float2(y0x - q2x, y0y - q2y);
    e1 = make_float2(y1x + q3x, y1y + q3y);
    e3 = make_float2(y1x - q3x, y1y - q3y);
  }
}
template <int H, bool INV>
DEVI void fft_r4_big(float2* z, float bwx, float bwy, int t) {
  constexpr int Q = H / 2;
  constexpr int oq = Q + (Q >> 4);
  const int zb = t + (t >> 4);
#pragma unroll
  for (int hb = 0; hb < 2; ++hb) {
    float2 e[4][4];
#pragma unroll
    for (int k = 0; k < 4; ++k) {
      const int K = hb * 4 + k;
      const int C1 = (256 * K) & (Q - 1), Ci = 1024 * K - 3 * C1;
      const int i0 = zb + Ci + (Ci >> 4);
#pragma unroll
      for (int m = 0; m < 4; ++m) e[k][m] = z[i0 + m * oq];
    }
#pragma unroll
    for (int k = 0; k < 4; ++k) {
      const int K = hb * 4 + k;
      const int C1 = (256 * K) & (Q - 1), Ci = 1024 * K - 3 * C1;
      const int i0 = zb + Ci + (Ci >> 4);
      const int mm = (C1 * 16) / H;
      const float rc = W32C[mm], rs = W32S[mm];
      float wx = bwx * rc + bwy * rs, wy = bwy * rc - bwx * rs;
      r4_bfly<INV>(e[k][0], e[k][1], e[k][2], e[k][3], wx, wy);
#pragma unroll
      for (int m = 0; m < 4; ++m) z[i0 + m * oq] = e[k][m];
    }
  }
  __syncthreads();
}
template <bool INV>
DEVI void fft_r4_small(float2* z, int h, float wx, float wy, int t) {
  const int q = h >> 1;
  const int jj = t & (q - 1);
  const int u = 4 * t - 3 * jj;
  float2* z0 = z + (u + (u >> 4));
  const int o1 = q + (q >= 16 ? (q >> 4) : 0);
  const int o2 = 2 * q + (q >= 16 ? (q >> 3) : (q == 8 ? 1 : 0));
  const int o3 = 3 * q + (q >= 16 ? ((3 * q) >> 4) : (q == 8 ? 1 : 0));
#pragma unroll
  for (int hb = 0; hb < 2; ++hb) {
    float2 e[4][4];
#pragma unroll
    for (int k = 0; k < 4; ++k) {
      const int K = hb * 4 + k;
      e[k][0] = z0[1088 * K]; e[k][1] = z0[1088 * K + o1]; e[k][2] = z0[1088 * K + o2]; e[k][3] = z0[1088 * K + o3];
    }
#pragma unroll
    for (int k = 0; k < 4; ++k) {
      const int K = hb * 4 + k;
      r4_bfly<INV>(e[k][0], e[k][1], e[k][2], e[k][3], wx, wy);
      z0[1088 * K] = e[k][0]; z0[1088 * K + o1] = e[k][1]; z0[1088 * K + o2] = e[k][2]; z0[1088 * K + o3] = e[k][3];
    }
  }
  __syncthreads();
}
struct FftTw { float x[5], y[5]; };
DEVI void fft_load_tw(FftTw& f, const float2* __restrict__ tw, int t) {
#pragma unroll
  for (int i = 0; i < 5; ++i) { float2 w = tw[(4096 >> i) + t]; f.x[i] = w.x; f.y[i] = w.y; }
}
DEVI void fft_dif_all(float2* z, const float2* __restrict__ tw, const FftTw& f, int t) {
  float2 wa = tw[256 + (t & 127)], wb = tw[64 + (t & 31)];
  float2 wn = tw[16 + (t & 15)];
  fft_r4_big<4096, false>(z, f.x[0], f.y[0], t);
  fft_r4_big<1024, false>(z, f.x[2], f.y[2], t);
  fft_r4_small<false>(z, 256, wa.x, wa.y, t);
  fft_r4_small<false>(z, 64, wb.x, wb.y, t);
#pragma unroll 1
  for (int h = 16; h >= 1; h >>= 1) {
    float2 w = wn;
    int hn = (h > 1) ? (h >> 1) : 1;
    wn = tw[hn + (t & (hn - 1))];
    fft_stage_small<false>(z, h, w.x, w.y, t);
  }
}
DEVI void fft_dit_all(float2* z, const float2* __restrict__ tw, const FftTw& f, int t) {
  float2 wa = tw[256 + (t & 127)], wb = tw[64 + (t & 31)];
  float2 wn = tw[1];
#pragma unroll 1
  for (int h = 1; h <= 16; h <<= 1) {
    float2 w = wn;
    int hn = (h < 16) ? (h << 1) : 16;
    wn = tw[hn + (t & (hn - 1))];
    fft_stage_small<true>(z, h, w.x, w.y, t);
  }
  fft_r4_small<true>(z, 64, wb.x, wb.y, t);
  fft_r4_small<true>(z, 256, wa.x, wa.y, t);
  fft_r4_big<1024, true>(z, f.x[2], f.y[2], t);
  fft_r4_big<4096, true>(z, f.x[0], f.y[0], t);
}
constexpr float W16C[8] = {1.f, 0.9238795325112867f, 0.7071067811865476f, 0.3826834323650898f, 0.f, -0.3826834323650898f, -0.7071067811865476f, -0.9238795325112867f};
constexpr float W16S[8] = {0.f, 0.3826834323650898f, 0.7071067811865476f, 0.9238795325112867f, 1.f, 0.9238795325112867f, 0.7071067811865476f, 0.3826834323650898f};
DEVI void fft16_dif(float (&xr)[16], float (&xi)[16], const float2* __restrict__ tw) {
#pragma unroll
  for (int hh = 8; hh >= 1; hh >>= 1)
#pragma unroll
    for (int m = 0; m < 8 / hh; ++m)
#pragma unroll
      for (int jj = 0; jj < hh; ++jj) {
        int k = m * 2 * hh + jj;
        const float wx_ = W16C[jj * (8 / hh)], wy_ = -W16S[jj * (8 / hh)];
        float dx = xr[k] - xr[k + hh], dy = xi[k] - xi[k + hh];
        xr[k] += xr[k + hh]; xi[k] += xi[k + hh];
        xr[k + hh] = dx * wx_ - dy * wy_; xi[k + hh] = dx * wy_ + dy * wx_;
      }
}
DEVI void fft16_dit_inv(float (&xr)[16], float (&xi)[16], const float2* __restrict__ tw) {
#pragma unroll
  for (int hh = 1; hh <= 8; hh <<= 1)
#pragma unroll
    for (int m = 0; m < 8 / hh; ++m)
#pragma unroll
      for (int jj = 0; jj < hh; ++jj) {
        int k = m * 2 * hh + jj;
        const float wx_ = W16C[jj * (8 / hh)], wy_ = -W16S[jj * (8 / hh)];
        float px = xr[k + hh] * wx_ + xi[k + hh] * wy_, py = xi[k + hh] * wx_ - xr[k + hh] * wy_;
        float ar = xr[k], ai = xi[k];
        xr[k] = ar + px; xi[k] = ai + py;
        xr[k + hh] = ar - px; xi[k + hh] = ai - py;
      }
}

DEVI void filter_tile(const Params& p, int j, int c, char* lds) {
  float2* z = (float2*)lds;
  float* w3s = (float*)(lds + 69632);
  float* red = w3s + 128;
  const float2* tw = (const float2*)(p.ws + OFF_TW);
  const float* H2 = (const float*)(p.ws + OFF_H2) + (size_t)j * 4096 * 64;
  __half2* HS = (__half2*)(p.ws + OFF_HSPEC);
  int t = tid();
  if (t < 128) w3s[t] = p.hy_fw3[((size_t)j * 64 + (t & 63)) * 2048 + (t >> 6) * 1024 + c];
  __syncthreads();
  const float lo = -3.0701134573253944f, hi = -15.350567286626972f;
  float delta = -(lo + (float)c * ((hi - lo) / 1023.f));
  float asum = 0.f;
#pragma unroll 1
  for (int qq = 0; qq < 16; ++qq) {
    int s = t + 256 * qq;
    const float4* hrow = (const float4*)(H2 + (size_t)s * 64);
    float hf = 0.f, hb = 0.f;
#pragma unroll 4
    for (int i4 = 0; i4 < 16; ++i4) {
      float4 hv = hrow[i4];
      float4 wf = *(const float4*)(w3s + i4 * 4);
      float4 wb = *(const float4*)(w3s + 64 + i4 * 4);
      hf += hv.x * wf.x + hv.y * wf.y + hv.z * wf.z + hv.w * wf.w;
      hb += hv.x * wb.x + hv.y * wb.y + hv.z * wb.z + hv.w * wb.w;
    }
    float tt = (float)s / 4095.f;
    float win = fexp(-tt * delta);
    float vf = hf * win, vb = hb * win;
    z[zi(s)] = make_float2(vf, 0.f);
    asum += fabsf(vf);
    if (s >= 1) { z[zi(8192 - s)] = make_float2(vb, 0.f); asum += fabsf(vb); }
  }
  if (t == 0) z[zi(4096)] = make_float2(0.f, 0.f);
  asum = wave_sum(asum);
  if ((t & 63) == 0) red[t >> 6] = asum;
  __syncthreads();
  float inv = 1.f / (red[0] + red[1] + red[2] + red[3]);
  { FftTw ftw; fft_load_tw(ftw, tw, t); fft_dif_all(z, tw, ftw, t); }
  float bias = p.hy_bias[j * 1024 + c];
  for (int k = t; k < 8192; k += 256) {
    float2 v = z[zi(k)];
    HS[(size_t)c * 8192 + k] = __floats2half2_rn(v.x * inv + bias, v.y * inv);
  }
  __syncthreads();
}

DEVI void layer_prep_phase(const Params& p, int layer, char* lds) {
  if (!(layer & 1)) {
    for (int tile = bid(); tile < 1024 + WT_T_EVEN; tile += gridDim.x) {
      if (tile < 1024) filter_tile(p, layer >> 1, tile, lds);
      else wt_tile(p, layer, tile - 1024, lds);
    }
  } else {
    for (int tile = bid(); tile < WT_T_ODD; tile += gridDim.x) wt_tile(p, layer, tile, lds);
  }
}

DEVI void norm_phase(const Params& p, int layer, int r) {
  int w = tid() >> 6, lane = tid() & 63;
  u16* hn = (u16*)(p.ws + OFF_HN);
  const float* modp = (const float*)(p.ws + OFF_MOD);
  const float* g = p.norm_g + layer * 1024;
  int nw = gridDim.x * 4;
  for (int tok0 = bid() * 4 + w; tok0 < RT; tok0 += 2 * nw) {
    float4 v[2][4]; float ss[2];
#pragma unroll
    for (int u = 0; u < 2; ++u) {
      int tok = min(tok0 + u * nw, RT - 1);
      int sl = tok >> 12, n = tok & 4095, sg = r * 4 + sl;
      const float* x = xsrc_ptr(p, layer, sg) + (size_t)n * D;
      ss[u] = 0.f;
#pragma unroll
      for (int i = 0; i < 4; ++i) { v[u][i] = *(const float4*)(x + i * 256 + lane * 4); ss[u] += v[u][i].x * v[u][i].x + v[u][i].y * v[u][i].y + v[u][i].z * v[u][i].z + v[u][i].w * v[u][i].w; }
    }
#pragma unroll
    for (int o = 32; o >= 1; o >>= 1) { ss[0] += __shfl_xor(ss[0], o); ss[1] += __shfl_xor(ss[1], o); }
#pragma unroll
    for (int u = 0; u < 2; ++u) {
      int tok = tok0 + u * nw;
      if (tok >= RT) break;
      int sl = tok >> 12, sg = r * 4 + sl;
      const float* md = modp + (size_t)(layer * 12 + sg) * 3072;
      float rs = __builtin_amdgcn_rsqf(ss[u] * (1.f / 1024.f) + 1e-6f);
#pragma unroll
      for (int i = 0; i < 4; ++i) {
        int c = i * 256 + lane * 4;
        float4 gg = *(const float4*)(g + c), sh = *(const float4*)(md + c), sc = *(const float4*)(md + 1024 + c);
        float o0 = v[u][i].x * rs * gg.x * (1.f + sc.x) + sh.x;
        float o1 = v[u][i].y * rs * gg.y * (1.f + sc.y) + sh.y;
        float o2 = v[u][i].z * rs * gg.z * (1.f + sc.z) + sh.z;
        float o3 = v[u][i].w * rs * gg.w * (1.f + sc.w) + sh.w;
        uint2 o; o.x = pack2(o0, o1); o.y = pack2(o2, o3);
        *(uint2*)(hn + (size_t)tok * 1024 + c) = o;
      }
    }
  }
}

DEVI void final_phase(const Params& p) {
  int w = tid() >> 6, lane = tid() & 63;
  int nw = gridDim.x * 4;
  const int NT = NSEQ * L;
  for (int tok0 = bid() * 4 + w; tok0 < NT; tok0 += 2 * nw) {
    float4 v[2][4]; float ss[2];
#pragma unroll
    for (int u = 0; u < 2; ++u) {
      int tok = min(tok0 + u * nw, NT - 1);
      const float* x = p.out + (size_t)tok * D;
      ss[u] = 0.f;
#pragma unroll
      for (int i = 0; i < 4; ++i) { v[u][i] = *(const float4*)(x + i * 256 + lane * 4); ss[u] += v[u][i].x * v[u][i].x + v[u][i].y * v[u][i].y + v[u][i].z * v[u][i].z + v[u][i].w * v[u][i].w; }
    }
#pragma unroll
    for (int o = 32; o >= 1; o >>= 1) { ss[0] += __shfl_xor(ss[0], o); ss[1] += __shfl_xor(ss[1], o); }
#pragma unroll
    for (int u = 0; u < 2; ++u) {
      int tok = tok0 + u * nw;
      if (tok >= NT) break;
      float* x = p.out + (size_t)tok * D;
      float rs = __builtin_amdgcn_rsqf(ss[u] * (1.f / 1024.f) + 1e-6f);
#pragma unroll
      for (int i = 0; i < 4; ++i) {
        int c = i * 256 + lane * 4;
        float4 gg = *(const float4*)(p.final_g + c);
        *(float4*)(x + c) = make_float4(v[u][i].x * rs * gg.x, v[u][i].y * rs * gg.y, v[u][i].z * rs * gg.z, v[u][i].w * rs * gg.w);
      }
    }
  }
}

DEVI void gemm_gload(const u16* __restrict__ xg, const u16* __restrict__ yg, int ldx, int ldy, int koff, u32x4 (&rx)[4], u32x4 (&ry)[4]) {
#pragma unroll
  for (int i = 0; i < 4; ++i) {
    rx[i] = *(const u32x4*)(xg + (size_t)(32 * i) * ldx + koff);
    ry[i] = *(const u32x4*)(yg + (size_t)(32 * i) * ldy + koff);
  }
}
DEVI void gemm_swrite(char* st, int lrow, int lch, const u32x4 (&rx)[4], const u32x4 (&ry)[4]) {
#pragma unroll
  for (int i = 0; i < 4; ++i) {
    int off = swz128(lrow + 32 * i, lch);
    *(u32x4*)(st + off) = rx[i]; *(u32x4*)(st + 16384 + off) = ry[i];
  }
}
DEVI void gemm_compute(const char* st, int wr, int wc, int lr, int q, f32x4 (&acc)[4][4]) {
#pragma unroll
  for (int ks = 0; ks < 2; ++ks) {
    bf16x8 xf[4], yf[4];
#pragma unroll
    for (int m = 0; m < 4; ++m) xf[m] = ldsfrag(st, swz128(wr * 64 + m * 16 + lr, ks * 4 + q));
#pragma unroll
    for (int n = 0; n < 4; ++n) yf[n] = ldsfrag(st + 16384, swz128(wc * 64 + n * 16 + lr, ks * 4 + q));
#pragma unroll
    for (int m = 0; m < 4; ++m)
#pragma unroll
      for (int n = 0; n < 4; ++n) acc[m][n] = mfma16(xf[m], yf[n], acc[m][n]);
  }
}
DEVI void gemm_glds_stage(const u16* __restrict__ X, int ldx, const u16* __restrict__ Y, int ldy, int koff, char* st, int w, int lane) {
#pragma unroll
  for (int i = 0; i < 4; ++i) {
    int row = 8 * w + 32 * i + (lane >> 3);
    int chunk = (lane & 7) ^ ((row >> 1) & 7);
    __builtin_amdgcn_global_load_lds((const unsigned*)(X + (size_t)row * ldx + chunk * 8 + koff), (unsigned*)(st + w * 1024 + i * 4096), 16, 0, 0);
    __builtin_amdgcn_global_load_lds((const unsigned*)(Y + (size_t)row * ldy + chunk * 8 + koff), (unsigned*)(st + 16384 + w * 1024 + i * 4096), 16, 0, 0);
  }
}
DEVI void gemm_core(const u16* __restrict__ X, int ldx, const u16* __restrict__ Y, int ldy, int K, f32x4 (&acc)[4][4], char* lds) {
  int t = tid(), w = t >> 6, lane = t & 63, q = lane >> 4, lr = lane & 15;
  int wr = w >> 1, wc = w & 1;
#pragma unroll
  for (int m = 0; m < 4; ++m)
#pragma unroll
    for (int n = 0; n < 4; ++n) acc[m][n] = f32x4{0.f, 0.f, 0.f, 0.f};
  int nk = K >> 6;
  gemm_glds_stage(X, ldx, Y, ldy, 0, lds, w, lane);
  asm volatile("s_waitcnt vmcnt(0)" ::: "memory");
  __syncthreads();
#pragma unroll 1
  for (int kt = 0; kt < nk; ++kt) {
    if (kt + 1 < nk) gemm_glds_stage(X, ldx, Y, ldy, (kt + 1) * 64, lds + ((kt + 1) & 1) * 32768, w, lane);
    gemm_compute(lds + (kt & 1) * 32768, wr, wc, lr, q, acc);
    asm volatile("s_waitcnt vmcnt(0)" ::: "memory");
    __syncthreads();
  }
}

DEVI void gemm_stage_bf16(const f32x4 (&acc)[4][4], char* lds, int wr, int wc, int lr, int q) {
#pragma unroll
  for (int m = 0; m < 4; ++m)
#pragma unroll
    for (int n = 0; n < 4; ++n) {
      int jrow = wc * 64 + n * 16 + lr, i0 = wr * 64 + m * 16 + 4 * q;
      uint2 o; o.x = pack2(acc[m][n][0], acc[m][n][1]); o.y = pack2(acc[m][n][2], acc[m][n][3]);
      *(uint2*)(lds + jrow * 272 + i0 * 2) = o;
    }
  __syncthreads();
}
DEVI void gemm_writeout(const char* lds, u16* dst, size_t pitch, int t) {
#pragma unroll
  for (int it = 0; it < 8; ++it) {
    int e = t + 256 * it; int row = e >> 4, c = e & 15;
    u32x4 v = *(const u32x4*)(lds + row * 272 + c * 16);
    *(u32x4*)(dst + (size_t)row * pitch + c * 8) = v;
  }
  __syncthreads();
}

DEVI void tile_decode(int t, int NT, int& mt, int& nt) {
  int grp = t / (8 * NT), rem = t % (8 * NT);
  nt = rem >> 3; mt = grp * 8 + (rem & 7);
}

DEVI void gemm_evin_phase(const Params& p, int j, char* lds) {
  const u16* A = (const u16*)(p.ws + OFF_HN);
  const u16* W = (const u16*)(p.ws + OFF_WT);
  u16* UT = (u16*)(p.ws + OFF_U);
  u16* US = (u16*)(p.ws + OFF_USSD);
  float* DT = (float*)(p.ws + OFF_DT);
  constexpr int NT = 57, MT = 128;
  int lane = tid() & 63, w = tid() >> 6, q = lane >> 4, lr = lane & 15, wr = w >> 1, wc = w & 1;
  for (int tile = vblock(); tile < MT * NT; tile += gridDim.x) {
    int mt, nt; tile_decode(tile, NT, mt, nt);
    f32x4 acc[4][4];
    const u16* Ap = A + (size_t)mt * 128 * 1024;
    const u16* Wp = W + (size_t)nt * 128 * 1024;
    bool cm = nt < 32;
    gemm_core(cm ? Ap : Wp, 1024, cm ? Wp : Ap, 1024, 1024, acc, lds);
    if (nt < 56) {
      gemm_stage_bf16(acc, lds, wr, wc, lr, q);
      u16* dst = cm ? (UT + ((size_t)(mt >> 5) * 4096 + nt * 128) * 4096 + ((mt * 128) & 4095))
                    : (US + (size_t)(mt * 128) * 3072 + (nt * 128 - 4096));
      gemm_writeout(lds, dst, cm ? 4096 : 3072, tid());
    } else {
#pragma unroll
      for (int m = 0; m < 4; ++m)
#pragma unroll
        for (int n = 0; n < 4; ++n) {
          int col = nt * 128 + wr * 64 + m * 16 + 4 * q;
          int tok = mt * 128 + wc * 64 + n * 16 + lr;
          if (col < 7200) *(float4*)(DT + (size_t)tok * 32 + (col - 7168)) = make_float4(acc[m][n][0], acc[m][n][1], acc[m][n][2], acc[m][n][3]);
        }
    }
  }
}

DEVI void gemm_odin_phase(const Params& p, int j, char* lds) {
  const u16* A = (const u16*)(p.ws + OFF_HN);
  const u16* W = (const u16*)(p.ws + OFF_WT);
  u16* U = (u16*)(p.ws + OFF_U);
  constexpr int NT = 32, MT = 128;
  int lane = tid() & 63, w = tid() >> 6, q = lane >> 4, lr = lane & 15, wr = w >> 1, wc = w & 1;
  for (int tile = vblock(); tile < MT * NT; tile += gridDim.x) {
    int mt, nt; tile_decode(tile, NT, mt, nt);
    f32x4 acc[4][4];
    gemm_core(W + (size_t)nt * 128 * 1024, 1024, A + (size_t)mt * 128 * 1024, 1024, 1024, acc, lds);
    gemm_stage_bf16(acc, lds, wr, wc, lr, q);
    gemm_writeout(lds, U + (size_t)(mt * 128) * 4096 + nt * 128, 4096, tid());
  }
}

DEVI void gemm_out_phase(const Params& p, int layer, int r, char* lds) {
  int j = layer >> 1;
  const u16* A = (const u16*)(p.ws + OFF_MIX);
  const u16* W = (const u16*)(p.ws + OFF_WT) + ((layer & 1) ? WTO_ODOUT : WTO_EVOUT);
  const float* modp = (const float*)(p.ws + OFF_MOD);
  constexpr int NT = 8, MT = 128;
  int lane = tid() & 63, w = tid() >> 6, q = lane >> 4, lr = lane & 15, wr = w >> 1, wc = w & 1;
  for (int tile = vblock(); tile < MT * NT; tile += gridDim.x) {
    int mt, nt; tile_decode(tile, NT, mt, nt);
    f32x4 acc[4][4];
    gemm_core(W + (size_t)nt * 128 * 2048, 2048, A + (size_t)mt * 128 * 2048, 2048, 2048, acc, lds);
    int sl = mt >> 5, sg = r * 4 + sl;
    const float* xs = xsrc_ptr(p, layer, sg);
    float* xo = p.out + (size_t)sg * L * D;
    const float* gate = modp + (size_t)(layer * 12 + sg) * 3072 + 2048;
#pragma unroll
    for (int m = 0; m < 4; ++m)
#pragma unroll
      for (int n = 0; n < 4; ++n) {
        int col = nt * 128 + wr * 64 + m * 16 + 4 * q;
        int tok = (mt * 128 + wc * 64 + n * 16 + lr) & 4095;
        float4 xv = *(const float4*)(xs + (size_t)tok * D + col);
        float4 gv = *(const float4*)(gate + col);
        float4 o = make_float4(xv.x + gv.x * acc[m][n][0], xv.y + gv.y * acc[m][n][1], xv.z + gv.z * acc[m][n][2], xv.w + gv.w * acc[m][n][3]);
        *(float4*)(xo + (size_t)tok * D + col) = o;
      }
  }
}

DEVI void hyena_tile(const Params& p, int j, int tile, char* lds) {
  int c = tile >> 1, pr = tile & 1;
  float2* z = (float2*)lds;
  float* zf = (float*)lds;
  const float2* tw = (const float2*)(p.ws + OFF_TW);
  const __half2* HS = (const __half2*)(p.ws + OFF_HSPEC) + (size_t)c * 8192;
  u16* UT = (u16*)(p.ws + OFF_U);
  int t = tid();
  const float* cw = p.hy_conv_w + (size_t)j * 3 * 3072;
  const float* cb = p.hy_conv_b + (size_t)j * 3072;
  int n0 = t * 16;
  FftTw ftw; fft_load_tw(ftw, tw, t);
#pragma unroll 1
  for (int s = 0; s < 2; ++s) {
    int sl = pr * 2 + s;
    float vfv[16];
#pragma unroll
    for (int k = 0; k < 16; ++k) vfv[k] = 1.f;
#pragma unroll
    for (int which = 1; which <= 2; ++which) {
      int col = which * 1024 + c;
      const u16* src = UT + ((size_t)sl * 4096 + col) * 4096;
      float raw[18];
      uint4 a = *(const uint4*)(src + n0), b = *(const uint4*)(src + n0 + 8);
      float f0[8], f1[8]; unpack8(a, f0); unpack8(b, f1);
#pragma unroll
      for (int k = 0; k < 8; ++k) { raw[1 + k] = f0[k]; raw[9 + k] = f1[k]; }
      raw[0] = (n0 > 0) ? bf2f(src[n0 - 1]) : 0.f;
      raw[17] = (n0 + 16 < 4096) ? bf2f(src[n0 + 16]) : 0.f;
      float w0 = cw[0 * 3072 + col], w1 = cw[1 * 3072 + col], w2 = cw[2 * 3072 + col], bb = cb[col];
#pragma unroll
      for (int k = 0; k < 16; ++k) vfv[k] *= (bb + w0 * raw[k] + w1 * raw[k + 1] + w2 * raw[k + 2]);
    }
#pragma unroll
    for (int k = 0; k < 16; ++k) zf[(17 * t + k) * 2 + s] = vfv[k];
  }
  for (int k = t; k < 4096; k += 256) z[zi(4096 + k)] = make_float2(0.f, 0.f);
  __syncthreads();
  fft_dif_all(z, tw, ftw, t);
  for (int k = t; k < 8192; k += 256) {
    float2 v = z[zi(k)], h = __half22float2(HS[k]);
    z[zi(k)] = make_float2(v.x * h.x - v.y * h.y, v.x * h.y + v.y * h.x);
  }
  __syncthreads();
  fft_dit_all(z, tw, ftw, t);
#pragma unroll 1
  for (int s = 0; s < 2; ++s) {
    int sl = pr * 2 + s;
    const u16* src = UT + ((size_t)sl * 4096 + c) * 4096;
    const u16* gsrc = UT + ((size_t)sl * 4096 + 3072 + c) * 4096;
    u16* dst = UT + ((size_t)sl * 4096 + 2048 + c) * 4096;
    float raw[18];
    uint4 a = *(const uint4*)(src + n0), b = *(const uint4*)(src + n0 + 8);
    float f0[8], f1[8]; unpack8(a, f0); unpack8(b, f1);
#pragma unroll
    for (int k = 0; k < 8; ++k) { raw[1 + k] = f0[k]; raw[9 + k] = f1[k]; }
    raw[0] = (n0 > 0) ? bf2f(src[n0 - 1]) : 0.f;
    raw[17] = (n0 + 16 < 4096) ? bf2f(src[n0 + 16]) : 0.f;
    float w0 = cw[0 * 3072 + c], w1 = cw[1 * 3072 + c], w2 = cw[2 * 3072 + c], bb = cb[c];
    uint4 ga = *(const uint4*)(gsrc + n0), gb = *(const uint4*)(gsrc + n0 + 8);
    float g0[8], g1[8]; unpack8(ga, g0); unpack8(gb, g1);
    float o0[8], o1[8];
#pragma unroll
    for (int k = 0; k < 8; ++k) {
      float x0 = bb + w0 * raw[k] + w1 * raw[k + 1] + w2 * raw[k + 2];
      float y = zf[(17 * t + k) * 2 + s] * (1.f / 8192.f);
      o0[k] = x0 * y * silu_f(g0[k]);
      float x0b = bb + w0 * raw[k + 8] + w1 * raw[k + 9] + w2 * raw[k + 10];
      float yb = zf[(17 * t + k + 8) * 2 + s] * (1.f / 8192.f);
      o1[k] = x0b * yb * silu_f(g1[k]);
    }
    *(uint4*)(dst + n0) = pack8(o0);
    *(uint4*)(dst + n0 + 8) = pack8(o1);
  }
  __syncthreads();
}

template <int NR, bool SILU>
DEVI void conv4_run(const u16* __restrict__ U, int ld, int col, int nb, const float* __restrict__ cw, const float* __restrict__ cb, int cidx, int cwld,
                    float (&out)[NR][8]) {
  float bias[8];
  {
    float4 b0 = *(const float4*)(cb + cidx), b1 = *(const float4*)(cb + cidx + 4);
    bias[0] = b0.x; bias[1] = b0.y; bias[2] = b0.z; bias[3] = b0.w; bias[4] = b1.x; bias[5] = b1.y; bias[6] = b1.z; bias[7] = b1.w;
  }
#pragma unroll
  for (int i = 0; i < NR; ++i)
#pragma unroll
    for (int e = 0; e < 8; ++e) out[i][e] = bias[e];
#pragma unroll
  for (int rr = 0; rr < NR + 3; ++rr) {
    int n = nb - 2 + rr;
    float f[8];
    if (n >= 0 && n < 4096) { uint4 v = *(const uint4*)(U + (size_t)n * ld + col); unpack8(v, f); }
    else {
#pragma unroll
      for (int e = 0; e < 8; ++e) f[e] = 0.f;
    }
#pragma unroll
    for (int k = 0; k < 4; ++k) {
      int i = rr - k;
      if (i >= 0 && i < NR) {
        float4 w0 = *(const float4*)(cw + (size_t)k * cwld + cidx), w1 = *(const float4*)(cw + (size_t)k * cwld + cidx + 4);
        out[i][0] += w0.x * f[0]; out[i][1] += w0.y * f[1]; out[i][2] += w0.z * f[2]; out[i][3] += w0.w * f[3];
        out[i][4] += w1.x * f[4]; out[i][5] += w1.y * f[5]; out[i][6] += w1.z * f[6]; out[i][7] += w1.w * f[7];
      }
    }
  }
  if (SILU) {
#pragma unroll
    for (int i = 0; i < NR; ++i)
#pragma unroll
      for (int e = 0; e < 8; ++e) out[i][e] = silu_f(out[i][e]);
  }
}

DEVI void act_phase(const Params& p, int layer) {
  int j = layer >> 1; bool odd = layer & 1;
  u16* XA = (u16*)(p.ws + OFF_XACT);
  const u16* Ub = (const u16*)(p.ws + (odd ? OFF_U : OFF_USSD));
  int ld = odd ? 4096 : 3072, cbase = odd ? 0 : 1024;
  const float* cw = (odd ? p.lru_conv_w : p.ssd_conv_w) + (size_t)j * 4 * 2048;
  const float* cb = (odd ? p.lru_conv_b : p.ssd_conv_b) + (size_t)j * 2048;
  int total = 256 * (RT / 8);
  for (int e = bid() * 256 + tid(); e < total; e += gridDim.x * 256) {
    int ch8 = e & 255, run = e >> 8;
    int tok0 = run * 8, sl = tok0 >> 12, nb = tok0 & 4095;
    float o[8][8];
    if (odd) conv4_run<8, false>(Ub + (size_t)sl * 4096 * ld, ld, cbase + ch8 * 8, nb, cw, cb, ch8 * 8, 2048, o);
    else conv4_run<8, true>(Ub + (size_t)sl * 4096 * ld, ld, cbase + ch8 * 8, nb, cw, cb, ch8 * 8, 2048, o);
#pragma unroll
    for (int i = 0; i < 8; ++i) *(uint4*)(XA + (size_t)(tok0 + i) * 2048 + ch8 * 8) = pack8(o[i]);
  }
}

DEVI void ssd_gload(const u16* __restrict__ XA, const float* __restrict__ DTR, int n0, int g, int hd, int dir, int t, u32x4 (&rc)[4], u32x4 (&rb)[4], u32x4 (&rxs)[2], float& dtraw) {
#pragma unroll
  for (int i = 0; i < 4; ++i) {
    int row = 2 * (t & 15) + (i & 1) + 32 * (i >> 1), ch8 = t >> 4;
    const u16* src = XA + (size_t)(n0 + row) * 2048 + g * 128 + ch8 * 8;
    rc[i] = *(const u32x4*)(src + 1536);
    rb[i] = *(const u32x4*)(src + 1024);
  }
#pragma unroll
  for (int i = 0; i < 2; ++i) {
    int row = 2 * (t & 15) + i + 32 * (t >> 7), c8 = (t >> 4) & 7;
    rxs[i] = *(const u32x4*)(XA + (size_t)(n0 + row) * 2048 + hd * 64 + c8 * 8);
  }
  int lane = t & 63;
  int n = dir ? (n0 + 63 - lane) : (n0 + lane);
  dtraw = DTR[(size_t)n * 32 + dir * 16 + hd];
}

DEVI void ssd_tile(const Params& p, int j, int tile, char* lds) {
  __builtin_amdgcn_s_setprio(3);
  int sl = tile >> 5, hd = (tile >> 1) & 15, dir = tile & 1;
  int g = hd >> 2;
  const u16* XA = (const u16*)(p.ws + OFF_XACT) + (size_t)sl * 4096 * 2048;
  const float* DTR = (const float*)(p.ws + OFF_DT) + (size_t)sl * 4096 * 32;
  u16* Yo = (u16*)(p.ws + (dir ? OFF_YB : OFF_YF)) + (size_t)sl * 4096 * 1024;
  char* Cs = lds; char* Bs = lds + 16384; char* BTs = lds + 32768; char* XTs = lds + 49152; char* Sb = lds + 57344;
  float* sm = (float*)(lds + 73728);
  int t = tid(), w = t >> 6, lane = t & 63, q = lane >> 4, lr = lane & 15, wi = w >> 1, wj = w & 1;
  float dtb = p.ssd_dt_bias[(j * 2 + dir) * 16 + hd];
  float aneg = -fexp(p.ssd_A_log[(j * 2 + dir) * 16 + hd]);
  f32x4 Sacc[4][2];
#pragma unroll
  for (int a = 0; a < 4; ++a)
#pragma unroll
    for (int b = 0; b < 2; ++b) Sacc[a][b] = f32x4{0.f, 0.f, 0.f, 0.f};
  for (int e = t; e < 1024; e += 256) *(uint4*)(Sb + e * 16) = make_uint4(0, 0, 0, 0);
  u32x4 rc[4], rb[4], rxs[2]; float dtraw;
  ssd_gload(XA, DTR, dir ? (4096 - 64) : 0, g, hd, dir, t, rc, rb, rxs, dtraw);

#pragma unroll 1
  for (int cc = 0; cc < 64; ++cc) {
    int par = cc & 1;
    float* dts = sm + par * 64; float* acum = sm + 128 + par * 64;
    int n0 = dir ? (4096 - 64 * (cc + 1)) : 64 * cc;
    if (w == 0) {
      float dtv = softplus_f(dtraw + dtb);
      float x = dtv * aneg;
#pragma unroll
      for (int o = 1; o < 64; o <<= 1) { float v = __shfl_up(x, o); if (lane >= o) x += v; }
      dts[lane] = dtv; acum[lane] = x;
    }
    lds_barrier();
    float alast = acum[63];
    {
      int ch8 = t >> 4, rl = t & 15;
#pragma unroll
      for (int pr = 0; pr < 2; ++pr) {
        int row0 = 2 * rl + 32 * pr;
        int le = dir ? (62 - row0) : row0;
        u32x4 ce = dir ? rc[2 * pr + 1] : rc[2 * pr], co = dir ? rc[2 * pr] : rc[2 * pr + 1];
        u32x4 be = dir ? rb[2 * pr + 1] : rb[2 * pr], bo = dir ? rb[2 * pr] : rb[2 * pr + 1];
        *(u32x4*)(Cs + swz256(le, ch8)) = ce; *(u32x4*)(Cs + swz256(le + 1, ch8)) = co;
        *(u32x4*)(Bs + swz256(le, ch8)) = be; *(u32x4*)(Bs + swz256(le + 1, ch8)) = bo;
        float fe[8], fo[8]; unpack8v(be, fe); unpack8v(bo, fo);
        float de = fexp(alast - acum[le]), dod = fexp(alast - acum[le + 1]);
        char* bt = BTs + (le & 7) * 2;
#pragma unroll
        for (int e2 = 0; e2 < 8; ++e2) {
          int nn = ch8 * 8 + e2;
          *(unsigned*)(bt + swz128(nn, le >> 3)) = pack2(fe[e2] * de, fo[e2] * dod);
        }
      }
    }
    {
      int c8 = (t >> 4) & 7, rl = t & 15;
      int row0 = 2 * rl + 32 * (t >> 7);
      int le = dir ? (62 - row0) : row0;
      u32x4 xe = dir ? rxs[1] : rxs[0], xo = dir ? rxs[0] : rxs[1];
      float fe[8], fo[8]; unpack8v(xe, fe); unpack8v(xo, fo);
      float de = dts[le], dod = dts[le + 1];
      char* xt = XTs + (le & 7) * 2;
#pragma unroll
      for (int e2 = 0; e2 < 8; ++e2) {
        int pp = c8 * 8 + e2;
        *(unsigned*)(xt + swz128(pp, le >> 3)) = pack2(fe[e2] * de, fo[e2] * dod);
      }
    }
    { int cn = min(cc + 1, 63); ssd_gload(XA, DTR, dir ? (4096 - 64 * (cn + 1)) : 64 * cn, g, hd, dir, t, rc, rb, rxs, dtraw); }
    __builtin_amdgcn_sched_barrier(0);
    lds_barrier();
    f32x4 aoff[2][2], cbm[2][2];
#pragma unroll
    for (int m = 0; m < 2; ++m)
#pragma unroll
      for (int n = 0; n < 2; ++n) { aoff[m][n] = f32x4{0.f, 0.f, 0.f, 0.f}; cbm[m][n] = f32x4{0.f, 0.f, 0.f, 0.f}; }
#pragma unroll
    for (int ks = 0; ks < 4; ++ks) {
      bf16x8 sf[2], bf[2], cf[2];
#pragma unroll
      for (int m = 0; m < 2; ++m) {
        int row = (2 * wi + m) * 16 + lr;
        sf[m] = ldsfrag(Sb, swz256(row, ks * 4 + q));
        bf[m] = ldsfrag(Bs, swz256(row, ks * 4 + q));
      }
#pragma unroll
      for (int n = 0; n < 2; ++n) cf[n] = ldsfrag(Cs, swz256((2 * wj + n) * 16 + lr, ks * 4 + q));
#pragma unroll
      for (int m = 0; m < 2; ++m)
#pragma unroll
        for (int n = 0; n < 2; ++n) { aoff[m][n] = mfma16(sf[m], cf[n], aoff[m][n]); cbm[m][n] = mfma16(bf[m], cf[n], cbm[m][n]); }
    }
    lds_barrier();
    char* Ms = Bs;
#pragma unroll
    for (int m = 0; m < 2; ++m)
#pragma unroll
      for (int n = 0; n < 2; ++n) {
        int l = (2 * wj + n) * 16 + lr; int s0 = (2 * wi + m) * 16 + 4 * q;
        float al = acum[l];
        float v[4];
#pragma unroll
        for (int rg = 0; rg < 4; ++rg) { int s = s0 + rg; v[rg] = (l >= s) ? cbm[m][n][rg] * fexp(al - acum[s]) : 0.f; }
        uint2 o; o.x = pack2(v[0], v[1]); o.y = pack2(v[2], v[3]);
        *(uint2*)(Ms + swz128(l, s0 >> 3) + (s0 & 7) * 2) = o;
      }
    lds_barrier();
    f32x4 adg[2][2];
#pragma unroll
    for (int m = 0; m < 2; ++m)
#pragma unroll
      for (int n = 0; n < 2; ++n) adg[m][n] = f32x4{0.f, 0.f, 0.f, 0.f};
    float cdec = fexp(alast);
#pragma unroll
    for (int a = 0; a < 4; ++a)
#pragma unroll
      for (int b = 0; b < 2; ++b) { Sacc[a][b][0] *= cdec; Sacc[a][b][1] *= cdec; Sacc[a][b][2] *= cdec; Sacc[a][b][3] *= cdec; }
#pragma unroll
    for (int ks = 0; ks < 2; ++ks) {
      bf16x8 xf[2], mf[2], btf[4], xyf[2];
#pragma unroll
      for (int m = 0; m < 2; ++m) xf[m] = ldsfrag(XTs, swz128((2 * wi + m) * 16 + lr, ks * 4 + q));
#pragma unroll
      for (int n = 0; n < 2; ++n) mf[n] = ldsfrag(Ms, swz128((2 * wj + n) * 16 + lr, ks * 4 + q));
#pragma unroll
      for (int m = 0; m < 2; ++m)
#pragma unroll
        for (int n = 0; n < 2; ++n) adg[m][n] = mfma16(xf[m], mf[n], adg[m][n]);
#pragma unroll
      for (int a = 0; a < 4; ++a) btf[a] = ldsfrag(BTs, swz128((4 * wi + a) * 16 + lr, ks * 4 + q));
#pragma unroll
      for (int b = 0; b < 2; ++b) xyf[b] = ldsfrag(XTs, swz128((2 * wj + b) * 16 + lr, ks * 4 + q));
#pragma unroll
      for (int a = 0; a < 4; ++a)
#pragma unroll
        for (int b = 0; b < 2; ++b) Sacc[a][b] = mfma16(btf[a], xyf[b], Sacc[a][b]);
    }
#pragma unroll
    for (int m = 0; m < 2; ++m)
#pragma unroll
      for (int n = 0; n < 2; ++n) {
        int l = (2 * wj + n) * 16 + lr; int p0 = (2 * wi + m) * 16 + 4 * q;
        float e = fexp(acum[l]);
        int ntok = dir ? (n0 + 63 - l) : (n0 + l);
        uint2 o; o.x = pack2(adg[m][n][0] + e * aoff[m][n][0], adg[m][n][1] + e * aoff[m][n][1]);
        o.y = pack2(adg[m][n][2] + e * aoff[m][n][2], adg[m][n][3] + e * aoff[m][n][3]);
        *(uint2*)(Yo + (size_t)ntok * 1024 + hd * 64 + p0) = o;
      }
#pragma unroll
    for (int a = 0; a < 4; ++a)
#pragma unroll
      for (int b = 0; b < 2; ++b) {
        int pc = (2 * wj + b) * 16 + lr; int nn0 = (4 * wi + a) * 16 + 4 * q;
        uint2 o; o.x = pack2(Sacc[a][b][0], Sacc[a][b][1]); o.y = pack2(Sacc[a][b][2], Sacc[a][b][3]);
        *(uint2*)(Sb + swz256(pc, nn0 >> 3) + (nn0 & 7) * 2) = o;
      }
  }
  __syncthreads();
  __builtin_amdgcn_s_setprio(0);
}

DEVI void even_mixer_phase(const Params& p, int j, char* lds) {
  int nb = gridDim.x, b = bid();
  if (nb == 512) {
    if (b < 128) ssd_tile(p, j, b, lds);
    else { for (int k = b - 128; k < 2048; k += 384) hyena_tile(p, j, k, lds); }
  } else {
    for (int tile = b; tile < 128 + 2048; tile += nb) {
      if (tile < 128) ssd_tile(p, j, tile, lds);
      else hyena_tile(p, j, tile - 128, lds);
    }
  }
}

DEVI void even_final_phase(const Params& p, int j, char* lds) {
  int t = tid(), w = t >> 6, lane = t & 63;
  const u16* US = (const u16*)(p.ws + OFF_USSD);
  const u16* YF = (const u16*)(p.ws + OFF_YF);
  const u16* YB = (const u16*)(p.ws + OFF_YB);
  const u16* UT = (const u16*)(p.ws + OFF_U);
  const u16* XA = (const u16*)(p.ws + OFF_XACT);
  u16* MIX = (u16*)(p.ws + OFF_MIX);
  constexpr int T_SSD = RT / 16;
  constexpr int T_HY = RS * 64 * 16;
  for (int tile = bid(); tile < T_SSD + T_HY; tile += gridDim.x) {
    if (tile < T_SSD) {
#pragma unroll 1
      for (int tk = w; tk < 16; tk += 4) {
        int tok = tile * 16 + tk;
        uint2 xr[4], yf[4], yb[4], zz[4];
#pragma unroll
        for (int g = 0; g < 4; ++g) {
          int ch = g * 256 + lane * 4;
          xr[g] = *(const uint2*)(XA + (size_t)tok * 2048 + ch);
          yf[g] = *(const uint2*)(YF + (size_t)tok * 1024 + ch);
          yb[g] = *(const uint2*)(YB + (size_t)tok * 1024 + ch);
          zz[g] = *(const uint2*)(US + (size_t)tok * 3072 + ch);
        }
        float y[4][4], ss[4];
#pragma unroll
        for (int g = 0; g < 4; ++g) {
          int ch = g * 256 + lane * 4;
          float dsk = p.ssd_D[j * 16 + (ch >> 6)];
          y[g][0] = (bflo(yf[g].x) + bflo(yb[g].x) + bflo(xr[g].x) * dsk) * silu_f(bflo(zz[g].x));
          y[g][1] = (bfhi(yf[g].x) + bfhi(yb[g].x) + bfhi(xr[g].x) * dsk) * silu_f(bfhi(zz[g].x));
          y[g][2] = (bflo(yf[g].y) + bflo(yb[g].y) + bflo(xr[g].y) * dsk) * silu_f(bflo(zz[g].y));
          y[g][3] = (bfhi(yf[g].y) + bfhi(yb[g].y) + bfhi(xr[g].y) * dsk) * silu_f(bfhi(zz[g].y));
          ss[g] = y[g][0] * y[g][0] + y[g][1] * y[g][1] + y[g][2] * y[g][2] + y[g][3] * y[g][3];
        }
#pragma unroll
        for (int o = 32; o >= 1; o >>= 1) {
#pragma unroll
          for (int g = 0; g < 4; ++g) ss[g] += __shfl_xor(ss[g], o);
        }
#pragma unroll
        for (int g = 0; g < 4; ++g) {
          int ch = g * 256 + lane * 4;
          float rs = __builtin_amdgcn_rsqf(ss[g] * (1.f / 256.f) + 1e-5f);
          float4 ng = *(const float4*)(p.ssd_norm_g + j * 1024 + ch);
          uint2 o; o.x = pack2(y[g][0] * rs * ng.x, y[g][1] * rs * ng.y); o.y = pack2(y[g][2] * rs * ng.z, y[g][3] * rs * ng.w);
          *(uint2*)(MIX + (size_t)tok * 2048 + 1024 + ch) = o;
        }
      }
    } else {
      int tt = tile - T_SSD;
      int sl = tt >> 10, tb = (tt >> 4) & 63, cbk = tt & 15;
      u16* ts = (u16*)lds;
#pragma unroll
      for (int i = 0; i < 2; ++i) {
        int e = t + 256 * i; int c = e >> 3, n8 = e & 7;
        uint4 v = *(const uint4*)(UT + ((size_t)sl * 4096 + 2048 + cbk * 64 + c) * 4096 + tb * 64 + n8 * 8);
        *(uint4*)(ts + c * 72 + n8 * 8) = v;
      }
      __syncthreads();
#pragma unroll
      for (int i = 0; i < 2; ++i) {
        int e = t + 256 * i; int n = e >> 3, c8 = e & 7;
        unsigned wv[4];
#pragma unroll
        for (int k = 0; k < 4; ++k) wv[k] = (unsigned)ts[(c8 * 8 + 2 * k) * 72 + n] | ((unsigned)ts[(c8 * 8 + 2 * k + 1) * 72 + n] << 16);
        *(uint4*)(MIX + ((size_t)sl * 4096 + tb * 64 + n) * 2048 + cbk * 64 + c8 * 8) = make_uint4(wv[0], wv[1], wv[2], wv[3]);
      }
      __syncthreads();
    }
  }
}

DEVI void lru_tile(const Params& p, int j, int tile, char* lds) {
  constexpr int CT = 64;
  constexpr int NCH = 4096 / CT;
  int sl = tile >> 6, h = (tile >> 2) & 15, dir = (tile >> 1) & 1, hf2 = tile & 1;
  const u16* XA = (const u16*)(p.ws + OFF_XACT) + (size_t)sl * 4096 * 2048;
  u16* Ho = (u16*)(p.ws + (dir ? OFF_HB : OFF_HF)) + (size_t)sl * 4096 * 2048;
  int t = tid(), w = t >> 6, lane = t & 63, q = lane >> 4, lr = lane & 15;
  char* Xs0 = lds;
  float* As = (float*)(lds + 32768 + w * 10240);
  float* Us = As + CT * 20;
  const u16* Wa = (const u16*)(p.ws + OFF_WT) + WTO_LRU + ((size_t)((dir * 2 + 0) * 16 + h)) * 16384;
  const u16* Wx = (const u16*)(p.ws + OFF_WT) + WTO_LRU + ((size_t)((dir * 2 + 1) * 16 + h)) * 16384;
  bf16x8 wa[4], wx[4];
#pragma unroll
  for (int ks = 0; ks < 4; ++ks) {
    int row = 64 * hf2 + w * 16 + lr;
    wa[ks] = *(const bf16x8*)(Wa + row * 128 + ks * 32 + q * 8);
    wx[ks] = *(const bf16x8*)(Wx + row * 128 + ks * 32 + q * 8);
  }
  float ba[4], bx[4], ls[4];
#pragma unroll
  for (int rg = 0; rg < 4; ++rg) {
    int n = 64 * hf2 + w * 16 + 4 * q + rg;
    int cidx = (j * 2 + dir) * 2048 + h * 128 + n;
    ba[rg] = -1.4426950408889634f * p.lru_b_a[cidx]; bx[rg] = -1.4426950408889634f * p.lru_b_x[cidx];
    ls[rg] = -8.f * 1.4426950408889634f * softplus_f(-p.lru_lam[cidx]);
  }
  float hstate = 0.f;
  u32x4 r0[4], r1[4];
#define LRU_LOAD(R, TILE) do { int _cn = min((TILE), NCH - 1); int _n1 = dir ? (4096 - CT * (_cn + 1)) : CT * _cn; \
    _Pragma("unroll") for (int i = 0; i < 4; ++i) { int e = t + 256 * i; R[i] = *(const u32x4*)(XA + (size_t)(_n1 + (e >> 4)) * 2048 + h * 128 + (e & 15) * 8); } } while (0)
  {
    int n0 = dir ? (4096 - CT) : 0;
#pragma unroll
    for (int i = 0; i < 4; ++i) {
      int e = t + 256 * i; int row = e >> 4, ch8 = e & 15;
      u32x4 v = *(const u32x4*)(XA + (size_t)(n0 + row) * 2048 + h * 128 + ch8 * 8);
      int l = dir ? (CT - 1 - row) : row;
      *(u32x4*)(Xs0 + swz256(l, ch8)) = v;
    }
    LRU_LOAD(r1, 1); LRU_LOAD(r0, 2);
  }
  lds_barrier();
#define LRU_CHUNK(CC, R) do {                                                                              \
    const int cc = (CC);                                                                                   \
    char* Xs = Xs0 + (cc & 1) * 16384;                                                                     \
    char* Xn = Xs0 + ((cc + 1) & 1) * 16384;                                                               \
    _Pragma("unroll") for (int i = 0; i < 4; ++i) {                                                        \
      int e = t + 256 * i; int row = e >> 4, ch8 = e & 15;                                                 \
      int l = dir ? (CT - 1 - row) : row;                                                                  \
      *(u32x4*)(Xn + swz256(l, ch8)) = R[i];                                                               \
    }                                                                                                      \
    LRU_LOAD(R, cc + 3);                                                                                   \
    __builtin_amdgcn_sched_barrier(0);                                                                     \
    _Pragma("unroll") for (int jh = 0; jh < 2; ++jh) {                                                     \
      f32x4 aa[2], ax[2];                                                                                  \
      _Pragma("unroll") for (int jt = 0; jt < 2; ++jt) { aa[jt] = f32x4{0.f, 0.f, 0.f, 0.f}; ax[jt] = f32x4{0.f, 0.f, 0.f, 0.f}; } \
      _Pragma("unroll") for (int ks = 0; ks < 4; ++ks) {                                                   \
        _Pragma("unroll") for (int jt = 0; jt < 2; ++jt) {                                                 \
          bf16x8 yf = ldsfrag(Xs, swz256((jh * 2 + jt) * 16 + lr, ks * 4 + q));                            \
          aa[jt] = mfma16(wa[ks], yf, aa[jt]); ax[jt] = mfma16(wx[ks], yf, ax[jt]);                        \
        }                                                                                                  \
      }                                                                                                    \
      _Pragma("unroll") for (int jt = 0; jt < 2; ++jt) {                                                   \
        int tok = (jh * 2 + jt) * 16 + lr; int nc = 64 * hf2 + w * 16 + 4 * q;                             \
        uint2 xr = *(const uint2*)(Xs + swz256(tok, nc >> 3) + (nc & 7) * 2);                              \
        float xv[4] = {bflo(xr.x), bfhi(xr.x), bflo(xr.y), bfhi(xr.y)};                                    \
        float av[4], uv[4];                                                                                \
        _Pragma("unroll") for (int rg = 0; rg < 4; ++rg) {                                                 \
          float r = rcp_f(1.f + __builtin_amdgcn_exp2f(fmaf(aa[jt][rg], -1.4426950408889634f, ba[rg])));   \
          float ig = rcp_f(1.f + __builtin_amdgcn_exp2f(fmaf(ax[jt][rg], -1.4426950408889634f, bx[rg])));  \
          float a = __builtin_amdgcn_exp2f(r * ls[rg]);                                                    \
          av[rg] = a;                                                                                      \
          uv[rg] = xv[rg] * ig * __builtin_amdgcn_sqrtf(fmaxf(fmaf(-a, a, 1.f), 0.f));                                      \
        }                                                                                                  \
        *(float4*)(As + tok * 20 + 4 * q) = make_float4(av[0], av[1], av[2], av[3]);                       \
        *(float4*)(Us + tok * 20 + 4 * q) = make_float4(uv[0], uv[1], uv[2], uv[3]);                       \
      }                                                                                                    \
    }                                                                                                      \
    asm volatile("s_waitcnt lgkmcnt(0)" ::: "memory");                                                     \
    {     \
      float hl_[16], pl_[16];                                                                              \
      {                                                                                                    \
        float av_[16], uv_[16];                                                                            \
        _Pragma("unroll") for (int k = 0; k < 16; ++k) { av_[k] = As[(16 * q + k) * 20 + lr]; uv_[k] = Us[(16 * q + k) * 20 + lr]; } \
        float hh = 0.f, pp = 1.f;                                                                          \
        _Pragma("unroll") for (int k = 0; k < 16; ++k) { hh = av_[k] * hh + uv_[k]; pp *= av_[k]; hl_[k] = hh; pl_[k] = pp; } \
      }                                                                                                    \
      float pe0 = __shfl(pl_[15], lr), he0 = __shfl(hl_[15], lr);                                          \
      float pe1 = __shfl(pl_[15], lr + 16), he1 = __shfl(hl_[15], lr + 16);                                \
      float pe2 = __shfl(pl_[15], lr + 32), he2 = __shfl(hl_[15], lr + 32);                                \
      float pe3 = __shfl(pl_[15], lr + 48), he3 = __shfl(hl_[15], lr + 48);                                \
      float c1 = pe0 * hstate + he0, c2 = pe1 * c1 + he1, c3 = pe2 * c2 + he2;                             \
      float cin = (q == 0) ? hstate : (q == 1) ? c1 : (q == 2) ? c2 : c3;                                  \
      hstate = pe3 * c3 + he3;                                                                             \
      _Pragma("unroll") for (int k = 0; k < 16; ++k) As[(16 * q + k) * 20 + lr] = hl_[k] + pl_[k] * cin;     \
    }                                                                                                      \
    asm volatile("s_waitcnt lgkmcnt(0)" ::: "memory");                                                     \
    {                                                        \
      float4 h0 = *(const float4*)(As + lane * 20), h1 = *(const float4*)(As + lane * 20 + 4);             \
      float4 h2 = *(const float4*)(As + lane * 20 + 8), h3 = *(const float4*)(As + lane * 20 + 12);        \
      int n0c = dir ? (4096 - CT * (cc + 1)) : CT * cc;                                                    \
      int ntok = dir ? (n0c + CT - 1 - lane) : (n0c + lane);                                               \
      u32x4 o0, o1;                                                                                        \
      o0[0] = pack2(h0.x, h0.y); o0[1] = pack2(h0.z, h0.w); o0[2] = pack2(h1.x, h1.y); o0[3] = pack2(h1.z, h1.w); \
      o1[0] = pack2(h2.x, h2.y); o1[1] = pack2(h2.z, h2.w); o1[2] = pack2(h3.x, h3.y); o1[3] = pack2(h3.z, h3.w); \
      u16* dst = Ho + (size_t)ntok * 2048 + h * 128 + 64 * hf2 + 16 * w;                                   \
      *(u32x4*)dst = o0; *(u32x4*)(dst + 8) = o1;                                                          \
    }                                                                                                      \
    lds_barrier();                                                                                         \
  } while (0)
#pragma unroll 1
  for (int c2 = 0; c2 < NCH; c2 += 2) {
    LRU_CHUNK(c2 + 0, r1);
    LRU_CHUNK(c2 + 1, r0);
  }
#undef LRU_CHUNK
#undef LRU_LOAD
  __syncthreads();
}

DEVI void lru_phase(const Params& p, int j, char* lds) {
  for (int tile = bid(); tile < 256; tile += gridDim.x) lru_tile(p, j, tile, lds);
}

DEVI void odd_final_phase(const Params& p) {
  const u16* HF = (const u16*)(p.ws + OFF_HF);
  const u16* HB = (const u16*)(p.ws + OFF_HB);
  const u16* U = (const u16*)(p.ws + OFF_U);
  u16* MIX = (u16*)(p.ws + OFF_MIX);
  size_t total = (size_t)RT * 256;
  for (size_t e = (size_t)bid() * 256 + tid(); e < total; e += (size_t)gridDim.x * 256) {
    size_t tok = e >> 8; int c = (int)(e & 255) * 8;
    uint4 a = *(const uint4*)(HF + tok * 2048 + c), b = *(const uint4*)(HB + tok * 2048 + c), gt = *(const uint4*)(U + tok * 4096 + 2048 + c);
    float fa[8], fb[8], fg[8], o[8];
    unpack8(a, fa); unpack8(b, fb); unpack8(gt, fg);
#pragma unroll
    for (int k = 0; k < 8; ++k) o[k] = (fa[k] + fb[k]) * silu_f(fg[k]);
    *(uint4*)(MIX + tok * 2048 + c) = pack8(o);
  }
}

constexpr int NPHASE = 82;
DEVI bool phase_exists(int ph) {
  if (ph == 0 || ph == 81) return true;
  int s = (ph - 1) % 20;
  if (s > 18) return false;
  if (s >= 1 && (s - 1) % 6 == 0) return false;
  return true;
}
DEVI void run_phase(const Params& p, int ph, char* lds) {
  if (ph == 0) { prep_phase(p, lds); return; }
  if (ph == 81) { final_phase(p); return; }
  int q = ph - 1, layer = q / 20, s = q % 20, j = layer >> 1;
  bool odd = layer & 1;
  if (s == 0) { layer_prep_phase(p, layer, lds); norm_phase(p, layer, 0); return; }
  int r = (s - 1) / 6, step = (s - 1) % 6;
  switch (step) {
    case 0: norm_phase(p, layer, r); break;
    case 1: if (odd) gemm_odin_phase(p, j, lds); else gemm_evin_phase(p, j, lds); break;
    case 2: act_phase(p, layer); break;
    case 3: if (odd) lru_phase(p, j, lds); else even_mixer_phase(p, j, lds); break;
    case 4: if (odd) odd_final_phase(p); else even_final_phase(p, j, lds); break;
    case 5: gemm_out_phase(p, layer, r, lds); if (r < NROUND - 1) norm_phase(p, layer, r + 1); break;
  }
}

__global__ void __launch_bounds__(NTHR, 2) fwd_kernel(Params p, int ph0, int ph1) {
  __shared__ __attribute__((aligned(16))) char lds[SMEM_BYTES];
  __shared__ uint4 xb_words;
  cg::grid_group grid = cg::this_grid();
  if (threadIdx.x == 0) xb_words = make_uint4(0u, 0u, 0u, 0u);
  __syncthreads();
  XcdBarrier xb = xcd_barrier_post((unsigned*)(p.ws + OFF_BAR), (volatile LAS unsigned*)&xb_words);
  for (int ph = ph0; ph < ph1; ++ph) {
    if (!phase_exists(ph)) continue;
    run_phase(p, ph, lds);
    if (ph + 1 < ph1) {
      if (ph1 < 0) grid.sync();
      xcd_barrier(xb);
    }
  }
}

extern "C" void kernel_launch(void* const* d_in, const int* in_sizes, int n_in, void* d_out, int out_size, void* d_ws, size_t ws_size,
                              hipStream_t stream) {
  if (ws_size < WS_NEED) { fprintf(stderr, "workspace too small: %zu < %zu\n", ws_size, (size_t)WS_NEED); return; }
  Params p{};
  const float** pp = (const float**)&p;
  for (int i = 0; i < 34; ++i) pp[i] = (const float*)d_in[i];
  p.out = (float*)d_out;
  p.ws = (char*)d_ws;
  static int grid_blocks = 0;
  if (!grid_blocks) {
    int dev = 0, cus = 0, per_cu = 0;
    hipGetDevice(&dev);
    hipDeviceGetAttribute(&cus, hipDeviceAttributeMultiprocessorCount, dev);
    hipOccupancyMaxActiveBlocksPerMultiprocessor(&per_cu, fwd_kernel, NTHR, 0);
    if (per_cu > 2) per_cu = 2;
    if (per_cu < 1) per_cu = 1;
    grid_blocks = cus * per_cu;
  }
  int ph0 = 0, ph1 = NPHASE;
  hipMemsetAsync((char*)d_ws + OFF_BAR, 0, SZ_BAR, stream);
  void* args[] = {&p, &ph0, &ph1};
  hipError_t e = hipLaunchCooperativeKernel((void*)fwd_kernel, dim3(grid_blocks), dim3(NTHR), args, 0, stream);
  if (e != hipSuccess) fprintf(stderr, "cooperative launch failed: %s (grid %d)\n", hipGetErrorString(e), grid_blocks);
}
```

```cpp
#include <hip/hip_runtime.h>
#include <hip/hip_cooperative_groups.h>
#include <hip/hip_fp16.h>
#include <cstdio>
namespace cg = cooperative_groups;

typedef unsigned short u16;
using bf16x8 = __attribute__((ext_vector_type(8))) short;
using f32x4 = __attribute__((ext_vector_type(4))) float;
using u32x4 = __attribute__((ext_vector_type(4))) unsigned int;
#define DEVI __device__ __forceinline__

constexpr int L = 4096, D = 1024, NSEQ = 12, RS = 4, RT = RS * L, NROUND = 3;
constexpr int EV_IN = 7200, EV_NPAD = 7296;
constexpr int NTHR = 256;
constexpr int SMEM_BYTES = 74752;

constexpr size_t OFF_WT = 0;
constexpr size_t SZ_WT = (size_t)EV_NPAD * 1024 * 2 + (size_t)1024 * 2048 * 2;
constexpr size_t WTO_EVOUT = (size_t)EV_NPAD * 1024;
constexpr size_t WTO_ODOUT = (size_t)4096 * 1024;
constexpr size_t WTO_LRU = WTO_ODOUT + (size_t)1024 * 2048;
constexpr size_t OFF_MOD = OFF_WT + SZ_WT;
constexpr size_t SZ_MOD = (size_t)4 * 12 * 3072 * 4;
constexpr size_t OFF_TW = OFF_MOD + SZ_MOD;
constexpr size_t SZ_TW = 8192 * 8;
constexpr size_t OFF_H2 = OFF_TW + SZ_TW;
constexpr size_t SZ_H2 = (size_t)2 * 4096 * 64 * 4;
constexpr size_t OFF_DT = OFF_H2 + SZ_H2;
constexpr size_t SZ_DT = (size_t)RT * 32 * 4;
constexpr size_t OFF_HSPEC = OFF_DT + SZ_DT;
constexpr size_t SZ_HSPEC = (size_t)1024 * 8192 * 4;
constexpr size_t OFF_HN = OFF_HSPEC + SZ_HSPEC;
constexpr size_t SZ_HN = (size_t)RT * 1024 * 2;
constexpr size_t OFF_U = OFF_HN + SZ_HN;
constexpr size_t SZ_U = (size_t)RT * 4096 * 2;
constexpr size_t OFF_U2 = OFF_U + SZ_U;
constexpr size_t SZ_U2 = (size_t)RT * 4096 * 2;
constexpr size_t OFF_XACT = OFF_U2 + SZ_U2;
constexpr size_t SZ_XACT = (size_t)RT * 2048 * 2;
constexpr size_t OFF_MIX = OFF_XACT + SZ_XACT;
constexpr size_t SZ_MIX = (size_t)RT * 2048 * 2;
constexpr size_t OFF_BAR = OFF_MIX + SZ_MIX;
constexpr size_t SZ_BAR = (size_t)3456 * 4;
constexpr size_t WS_NEED = OFF_BAR + 16384;
constexpr size_t OFF_YF = OFF_HN;
constexpr size_t OFF_USSD = OFF_U2;
constexpr size_t OFF_YB = OFF_U2 + (size_t)RT * 3072 * 2;
constexpr size_t OFF_HF = OFF_U2;
constexpr size_t OFF_HB = OFF_U2 + (size_t)RT * 2048 * 2;

#define XB_TMO      128
#define XB_XCNT(j)  (256  + 64 * (j))
#define XB_XSUB(j)  (1280 + 64 * (j))
#define XB_XGEN(j)  (2304 + 64 * (j))
#define XB_TOP      3328
#define XB_TOPGEN   3392
#define XCD_BAR_WORDS 3456
#define XB_SPIN_CAP (1u << 22)
#define LAS __attribute__((address_space(3)))

__device__ __forceinline__ unsigned xb_ld(unsigned* p)              { return __hip_atomic_load(p, __ATOMIC_RELAXED, __HIP_MEMORY_SCOPE_AGENT); }
__device__ __forceinline__ unsigned xb_add(unsigned* p, unsigned v) { return __hip_atomic_fetch_add(p, v, __ATOMIC_RELAXED, __HIP_MEMORY_SCOPE_AGENT); }
__device__ __forceinline__ unsigned xb_xcc_id() { return (unsigned)__builtin_amdgcn_s_getreg((3 << 11) | 20) & 0xFu; }
#define XB_SPIN(cond, bar) do { unsigned _sp = 0; while (cond) { __builtin_amdgcn_s_sleep(1); \
    if ((++_sp & 255u) == 0u) { if (xb_ld(&(bar)[XB_TMO])) break; if (_sp > XB_SPIN_CAP) { atomicAdd(&(bar)[XB_TMO], 1u); break; } } } } while (0)

struct XcdBarrier {
    unsigned* bar; unsigned x;
    volatile LAS unsigned* st;
};

__device__ __forceinline__ XcdBarrier xcd_barrier_post(unsigned* bar, volatile LAS unsigned* st) {
    XcdBarrier b; b.bar = bar; b.x = xb_xcc_id(); b.st = st;
    if (threadIdx.x == 0) (void)xb_add(&bar[XB_XCNT(b.x)], 1u);
    return b;
}
__device__ __forceinline__ void xcd_barrier_complete(unsigned* bar, unsigned x, unsigned& nloc, unsigned& nx) {
    const unsigned G = gridDim.x * gridDim.y * gridDim.z;
    unsigned sum, cnt, mine, sp = 0u;
    for (;;) {
        sum = 0u; cnt = 0u; mine = 0u;
#pragma unroll
        for (unsigned j = 0; j < 16; ++j) { const unsigned c = xb_ld(&bar[XB_XCNT(j)]); sum += c; cnt += (c > 0u) ? 1u : 0u; mine = (j == x) ? c : mine; }
        if (sum == G) break;
        __builtin_amdgcn_s_sleep(1);
        if ((++sp & 255u) == 0u) { if (xb_ld(&bar[XB_TMO])) break; if (sp > XB_SPIN_CAP) { atomicAdd(&bar[XB_TMO], 1u); break; } }
    }
    nloc = mine > 0u ? mine : 1u; nx = cnt > 0u ? cnt : 1u;
}

__device__ __forceinline__ void xcd_barrier(const XcdBarrier& b) {
    asm volatile("s_waitcnt vmcnt(0)" ::: "memory");
    __syncthreads();
    if (threadIdx.x == 0) {
        unsigned* bar = b.bar;
        __builtin_amdgcn_s_waitcnt(0);
        unsigned nloc = b.st[0], nx = b.st[1];
        if (nloc == 0u) { xcd_barrier_complete(bar, b.x, nloc, nx); b.st[0] = nloc; b.st[1] = nx; }
        const unsigned old = xb_add(&bar[XB_XSUB(b.x)], 1u);
        const unsigned gen = old / nloc;
        if (old + 1u == (gen + 1u) * nloc) {
            __builtin_amdgcn_fence(__ATOMIC_RELEASE, "agent");
            asm volatile("s_waitcnt vmcnt(0)" ::: "memory");
            const unsigned og = xb_add(&bar[XB_TOP], 1u);
            const unsigned tg = og / nx;
            if (og + 1u == (tg + 1u) * nx) xb_add(&bar[XB_TOPGEN], 1u);
            else XB_SPIN(xb_ld(&bar[XB_TOPGEN]) == tg, bar);
            __builtin_amdgcn_fence(__ATOMIC_ACQUIRE, "agent");
            xb_add(&bar[XB_XGEN(b.x)], 1u);
            asm volatile("s_waitcnt vmcnt(0)" ::: "memory");
        } else {
            XB_SPIN(xb_ld(&bar[XB_XGEN(b.x)]) == gen, bar);
            __builtin_amdgcn_fence(__ATOMIC_ACQUIRE, "agent");
            asm volatile("s_waitcnt vmcnt(0)" ::: "memory");
        }
    }
    __syncthreads();
}


struct Params {
  const float *x_prompt, *x_sample, *c_prompt, *c_sample, *mod_w, *mod_b, *norm_g, *final_g;
  const float *ev_w_in, *ev_w_out, *hy_conv_w, *hy_conv_b, *hy_fw1, *hy_fb1, *hy_fw2, *hy_fb2, *hy_fw3, *hy_freq, *hy_bias;
  const float *ssd_conv_w, *ssd_conv_b, *ssd_dt_bias, *ssd_A_log, *ssd_D, *ssd_norm_g;
  const float *od_w_in, *od_w_out, *lru_conv_w, *lru_conv_b, *lru_w_a, *lru_b_a, *lru_w_x, *lru_b_x, *lru_lam;
  float* out;
  char* ws;
};

DEVI unsigned pack2(float a, float b) { unsigned r; asm("v_cvt_pk_bf16_f32 %0, %1, %2" : "=v"(r) : "v"(a), "v"(b)); return r; }
DEVI u16 f2bf(float f) { return (u16)(pack2(f, 0.f) & 0xffffu); }
DEVI float bf2f(u16 h) { return __uint_as_float(((unsigned)h) << 16); }
DEVI float bflo(unsigned w) { return __uint_as_float(w << 16); }
DEVI float bfhi(unsigned w) { return __uint_as_float(w & 0xffff0000u); }
DEVI void unpack8v(u32x4 v, float (&f)[8]) {
  f[0] = bflo(v[0]); f[1] = bfhi(v[0]); f[2] = bflo(v[1]); f[3] = bfhi(v[1]);
  f[4] = bflo(v[2]); f[5] = bfhi(v[2]); f[6] = bflo(v[3]); f[7] = bfhi(v[3]);
}
DEVI void unpack8(uint4 v, float (&f)[8]) {
  f[0] = bflo(v.x); f[1] = bfhi(v.x); f[2] = bflo(v.y); f[3] = bfhi(v.y);
  f[4] = bflo(v.z); f[5] = bfhi(v.z); f[6] = bflo(v.w); f[7] = bfhi(v.w);
}
DEVI uint4 pack8(const float (&f)[8]) {
  uint4 v; v.x = pack2(f[0], f[1]); v.y = pack2(f[2], f[3]); v.z = pack2(f[4], f[5]); v.w = pack2(f[6], f[7]); return v;
}
DEVI float rcp_f(float x) { return __builtin_amdgcn_rcpf(x); }
DEVI float fexp(float x) { return __builtin_amdgcn_exp2f(x * 1.4426950408889634f); }
DEVI float silu_f(float x) { return x * rcp_f(1.f + fexp(-x)); }
DEVI float sigmoid_f(float x) { return rcp_f(1.f + fexp(-x)); }
DEVI float softplus_f(float x) {
  float e = fexp(fminf(x, 30.f));
  float small = e * (1.f - e * (0.5f - e * 0.33333334f));
  float big = __builtin_amdgcn_logf(1.f + e) * 0.6931471805599453f;
  float r = (e < 0.01f) ? small : big;
  return x > 20.f ? x : r;
}
DEVI float sin_f(float x) { return sinpif(x * 0.3183098861837907f); }
DEVI int swz256(int row, int c16) { return row * 256 + ((c16 ^ (row & 15)) << 4); }
DEVI int swz128(int row, int c16) { return row * 128 + ((c16 ^ ((row >> 1) & 7)) << 4); }
DEVI bf16x8 ldsfrag(const char* base, int off) { return *(const bf16x8*)(base + off); }
DEVI f32x4 mfma16(bf16x8 a, bf16x8 b, f32x4 c) { return __builtin_amdgcn_mfma_f32_16x16x32_bf16(a, b, c, 0, 0, 0); }
DEVI float wave_sum(float v) {
#pragma unroll
  for (int o = 32; o >= 1; o >>= 1) v += __shfl_xor(v, o);
  return v;
}
DEVI void lds_barrier() { asm volatile("s_waitcnt lgkmcnt(0)\n\ts_barrier" ::: "memory"); }
DEVI int tid() { int t = threadIdx.x; asm volatile("" : "+v"(t)); return t; }
DEVI int bid() { int b = blockIdx.x; asm volatile("" : "+s"(b)); return b; }
DEVI int vblock() {
  int nb = gridDim.x, b = bid();
  return (nb & 7) ? b : ((b & 7) * (nb >> 3) + (b >> 3));
}
DEVI const float* xsrc_ptr(const Params& p, int layer, int sg) {
  if (layer == 0) return sg < 8 ? p.x_prompt + (size_t)sg * L * D : p.x_sample + (size_t)(sg - 8) * L * D;
  return p.out + (size_t)sg * L * D;
}

DEVI void tconv_tile(const float* src, int K, int N, u16* dst, int kt, int nt, float* lds) {
  int t = tid();
#pragma unroll 4
  for (int i = 0; i < 16; ++i) {
    int e = t + 256 * i; int kk = e >> 6, nn = e & 63; int n = nt * 64 + nn;
    float v = (n < N) ? src[(size_t)(kt * 64 + kk) * N + n] : 0.f;
    lds[nn * 65 + kk] = v;
  }
  __syncthreads();
#pragma unroll
  for (int i = 0; i < 2; ++i) {
    int e = t + 256 * i; int nn = e >> 3, c8 = e & 7;
    float f[8];
#pragma unroll
    for (int k = 0; k < 8; ++k) f[k] = lds[nn * 65 + c8 * 8 + k];
    *(uint4*)(dst + (size_t)(nt * 64 + nn) * K + kt * 64 + c8 * 8) = pack8(f);
  }
  __syncthreads();
}

DEVI void mod_tile(const Params& p, int tile, char* lds) {
  int layer = tile / 48, nchunk = tile % 48;
  int t = tid();
  float* cs = (float*)lds;
  for (int e = t; e < 12288; e += 256) {
    int b = e >> 10, k = e & 1023;
    float c = b < 8 ? p.c_prompt[b * 1024 + k] : p.c_sample[(b - 8) * 1024 + k];
    cs[e] = silu_f(c);
  }
  __syncthreads();
  int nn = t & 63, ks = t >> 6;
  int n = nchunk * 64 + nn;
  float acc[12];
#pragma unroll
  for (int b = 0; b < 12; ++b) acc[b] = 0.f;
  const float* w = p.mod_w + (size_t)layer * 1024 * 3072 + n;
  for (int k = ks * 256; k < ks * 256 + 256; ++k) {
    float wv = w[(size_t)k * 3072];
#pragma unroll
    for (int b = 0; b < 12; ++b) acc[b] += cs[b * 1024 + k] * wv;
  }
  float* red = cs + 12288;
#pragma unroll
  for (int b = 0; b < 12; ++b) red[(ks * 12 + b) * 64 + nn] = acc[b];
  __syncthreads();
  float* modp = (float*)(p.ws + OFF_MOD);
  for (int e = t; e < 768; e += 256) {
    int b = e >> 6, n2 = e & 63;
    float s = red[(0 * 12 + b) * 64 + n2] + red[(1 * 12 + b) * 64 + n2] + red[(2 * 12 + b) * 64 + n2] + red[(3 * 12 + b) * 64 + n2];
    modp[(size_t)(layer * 12 + b) * 3072 + nchunk * 64 + n2] = s + p.mod_b[layer * 3072 + nchunk * 64 + n2];
  }
  __syncthreads();
}

DEVI void h2_tile(const Params& p, int tile, char* lds) {
  int j = tile >> 10, pos0 = (tile & 1023) * 4;
  int t = tid();
  float* zs = (float*)lds;
  float* h1s = zs + 4 * 36;
  if (t < 4 * 33) {
    int pp = t / 33, e = t % 33; int pos = pos0 + pp;
    float val;
    if (e == 0) val = (float)pos / 4095.f;
    else {
      int b = (e - 1) & 15;
      float f = 1e-4f + (float)b * ((15.f - 1e-4f) / 15.f);
      float rev = f * (float)pos * (1.f / 4096.f);
      rev -= floorf(rev);
      float s, c; sincospif(2.f * rev, &s, &c);
      val = (e <= 16) ? c : -s;
    }
    zs[pp * 36 + e] = val;
  }
  __syncthreads();
  int pp = t >> 6, jj = t & 63;
  float fr = p.hy_freq[j * 64 + jj];
  float a = p.hy_fb1[j * 64 + jj];
  for (int e = 0; e < 33; ++e) a += zs[pp * 36 + e] * p.hy_fw1[(j * 33 + e) * 64 + jj];
  h1s[pp * 64 + jj] = sin_f(fr * a);
  __syncthreads();
  a = p.hy_fb2[j * 64 + jj];
  for (int i = 0; i < 64; ++i) a += h1s[pp * 64 + i] * p.hy_fw2[(j * 64 + i) * 64 + jj];
  float* H2 = (float*)(p.ws + OFF_H2);
  H2[((size_t)j * 4096 + pos0 + pp) * 64 + jj] = sin_f(fr * a);
  __syncthreads();
}

constexpr int PREP_T_MOD = 192;
constexpr int PREP_T_TW = 32;
constexpr int PREP_T_H2 = 2048;
constexpr int PREP_TOTAL = PREP_T_MOD + PREP_T_TW + PREP_T_H2;

DEVI void prep_phase(const Params& p, char* lds) {
  for (int tile = bid(); tile < PREP_TOTAL; tile += gridDim.x) {
    int t = tile;
    if (t < PREP_T_MOD) { mod_tile(p, t, lds); continue; }
    t -= PREP_T_MOD;
    if (t < PREP_T_TW) {
      int k = t * 256 + tid();
      int hh = (k == 0) ? 1 : (1 << (31 - __clz(k)));
      int jj = (k == 0) ? 0 : (k - hh);
      float s, c; sincospif((float)jj / (float)hh, &s, &c);
      ((float2*)(p.ws + OFF_TW))[k] = make_float2(c, -s);
      continue;
    }
    t -= PREP_T_TW;
    h2_tile(p, t, lds);
  }
}

constexpr int WT_T_EVIN = 16 * 114, WT_T_EVOUT = 32 * 16, WT_T_EVEN = WT_T_EVIN + WT_T_EVOUT;
constexpr int WT_T_ODIN = 16 * 64, WT_T_ODOUT = 32 * 16, WT_T_LRU = 64 * 4, WT_T_ODD = WT_T_ODIN + WT_T_ODOUT + WT_T_LRU;
DEVI void wt_tile(const Params& p, int layer, int t, char* lds) {
  int j = layer >> 1;
  u16* WT = (u16*)(p.ws + OFF_WT);
  if (!(layer & 1)) {
    if (t < WT_T_EVIN) { tconv_tile(p.ev_w_in + (size_t)j * 1024 * EV_IN, 1024, EV_IN, WT, t % 16, t / 16, (float*)lds); return; }
    t -= WT_T_EVIN;
    tconv_tile(p.ev_w_out + (size_t)j * 2048 * 1024, 2048, 1024, WT + WTO_EVOUT, t % 32, t / 32, (float*)lds);
  } else {
    if (t < WT_T_ODIN) { tconv_tile(p.od_w_in + (size_t)j * 1024 * 4096, 1024, 4096, WT, t % 16, t / 16, (float*)lds); return; }
    t -= WT_T_ODIN;
    if (t < WT_T_ODOUT) { tconv_tile(p.od_w_out + (size_t)j * 2048 * 1024, 2048, 1024, WT + WTO_ODOUT, t % 32, t / 32, (float*)lds); return; }
    t -= WT_T_ODOUT;
    int m = t >> 2, sub = t & 3;
    int dir = m >> 5, gate = (m >> 4) & 1, h = m & 15;
    const float* src = (gate ? p.lru_w_x : p.lru_w_a) + ((size_t)((j * 2 + dir) * 16 + h)) * 16384;
    tconv_tile(src, 128, 128, WT + WTO_LRU + (size_t)m * 16384, sub & 1, sub >> 1, (float*)lds);
  }
}

DEVI int zi(int n) { return n + (n >> 4); }
template <bool INV>
DEVI void bfly_store(float2* z, int i0, int i1, float ax, float ay, float cx, float cy, float wx, float wy) {
  if (!INV) {
    float dx = ax - cx, dy = ay - cy;
    z[i0] = make_float2(ax + cx, ay + cy);
    z[i1] = make_float2(dx * wx - dy * wy, dx * wy + dy * wx);
  } else {
    float px = cx * wx + cy * wy, py = cy * wx - cx * wy;
    z[i0] = make_float2(ax + px, ay + py);
    z[i1] = make_float2(ax - px, ay - py);
  }
}
constexpr float W32C[16] = {1.0000000000f, 0.9807852804f, 0.9238795325f, 0.8314696123f, 0.7071067812f, 0.5555702330f, 0.3826834324f, 0.1950903220f, 0.0000000000f, -0.1950903220f, -0.3826834324f, -0.5555702330f, -0.7071067812f, -0.8314696123f, -0.9238795325f, -0.9807852804f};
constexpr float W32S[16] = {0.0000000000f, 0.1950903220f, 0.3826834324f, 0.5555702330f, 0.7071067812f, 0.8314696123f, 0.9238795325f, 0.9807852804f, 1.0000000000f, 0.9807852804f, 0.9238795325f, 0.8314696123f, 0.7071067812f, 0.5555702330f, 0.3826834324f, 0.1950903220f};
template <int H, bool INV>
DEVI void fft_stage_big(float2* z, float bwx, float bwy, int t) {
  const int zb = t + (t >> 4);
  constexpr int hz = H + (H >> 4);
#pragma unroll
  for (int hb = 0; hb < 2; ++hb) {
    float ax[8], ay[8], cx[8], cy[8];
#pragma unroll
    for (int k = 0; k < 8; ++k) {
      const int K = hb * 8 + k;
      const int C1 = (256 * K) & (H - 1), Ci = 512 * K - C1;
      const int i0 = zb + Ci + (Ci >> 4);
      float2 a = z[i0], c = z[i0 + hz];
      ax[k] = a.x; ay[k] = a.y; cx[k] = c.x; cy[k] = c.y;
    }
#pragma unroll
    for (int k = 0; k < 8; ++k) {
      const int K = hb * 8 + k;
      const int C1 = (256 * K) & (H - 1), Ci = 512 * K - C1;
      const int i0 = zb + Ci + (Ci >> 4);
      const int m = (C1 * 16) / H;
      const float rc = W32C[m], rs = W32S[m];
      float wx = bwx * rc + bwy * rs, wy = bwy * rc - bwx * rs;
      bfly_store<INV>(z, i0, i0 + hz, ax[k], ay[k], cx[k], cy[k], wx, wy);
    }
  }
  __syncthreads();
}
template <bool INV>
DEVI void fft_stage_small(float2* z, int h, float wx, float wy, int t) {
  const int jj = t & (h - 1);
  const int u = 2 * t - jj;
  float2* z0 = z + (u + (u >> 4));
  float2* z1 = z0 + (h + (h >= 16 ? (h >> 4) : 0));
#pragma unroll
  for (int hb = 0; hb < 2; ++hb) {
    float ax[8], ay[8], cx[8], cy[8];
#pragma unroll
    for (int k = 0; k < 8; ++k) {
      const int K = hb * 8 + k;
      float2 a = z0[544 * K], c = z1[544 * K];
      ax[k] = a.x; ay[k] = a.y; cx[k] = c.x; cy[k] = c.y;
    }
#pragma unroll
    for (int k = 0; k < 8; ++k) {
      const int K = hb * 8 + k;
      if (!INV) {
        float dx = ax[k] - cx[k], dy = ay[k] - cy[k];
        z0[544 * K] = make_float2(ax[k] + cx[k], ay[k] + cy[k]);
        z1[544 * K] = make_float2(dx * wx - dy * wy, dx * wy + dy * wx);
      } else {
        float px = cx[k] * wx + cy[k] * wy, py = cy[k] * wx - cx[k] * wy;
        z0[544 * K] = make_float2(ax[k] + px, ay[k] + py);
        z1[544 * K] = make_float2(ax[k] - px, ay[k] - py);
      }
    }
  }
  __syncthreads();
}
template <bool INV>
DEVI void r4_bfly(float2& e0, float2& e1, float2& e2, float2& e3, float w1x, float w1y) {
  float w2x = w1x * w1x - w1y * w1y, w2y = 2.f * w1x * w1y;
  if (!INV) {
    float y0x = e0.x + e2.x, y0y = e0.y + e2.y;
    float dx = e0.x - e2.x, dy = e0.y - e2.y;
    float y2x = dx * w1x - dy * w1y, y2y = dx * w1y + dy * w1x;
    float y1x = e1.x + e3.x, y1y = e1.y + e3.y;
    float ex = e1.x - e3.x, ey = e1.y - e3.y;
    float tx = ex * w1x - ey * w1y, ty = ex * w1y + ey * w1x;
    float y3x = ty, y3y = -tx;
    e0 = make_float2(y0x + y1x, y0y + y1y);
    float fx = y0x - y1x, fy = y0y - y1y;
    e1 = make_float2(fx * w2x - fy * w2y, fx * w2y + fy * w2x);
    e2 = make_float2(y2x + y3x, y2y + y3y);
    float gx = y2x - y3x, gy = y2y - y3y;
    e3 = make_float2(gx * w2x - gy * w2y, gx * w2y + gy * w2x);
  } else {
    float p1x = e1.x * w2x + e1.y * w2y, p1y = e1.y * w2x - e1.x * w2y;
    float p3x = e3.x * w2x + e3.y * w2y, p3y = e3.y * w2x - e3.x * w2y;
    float y0x = e0.x + p1x, y0y = e0.y + p1y, y1x = e0.x - p1x, y1y = e0.y - p1y;
    float y2x = e2.x + p3x, y2y = e2.y + p3y, y3x = e2.x - p3x, y3y = e2.y - p3y;
    float q2x = y2x * w1x + y2y * w1y, q2y = y2y * w1x - y2x * w1y;
    float rx = y3x * w1x + y3y * w1y, ry = y3y * w1x - y3x * w1y;
    float q3x = -ry, q3y = rx;
    e0 = make_float2(y0x + q2x, y0y + q2y);
    e2 = make_float2(y0x - q2x, y0y - q2y);
    e1 = make_float2(y1x + q3x, y1y + q3y);
    e3 = make_float2(y1x - q3x, y1y - q3y);
  }
}
template <int H, bool INV>
DEVI void fft_r4_big(float2* z, float bwx, float bwy, int t) {
  constexpr int Q = H / 2;
  constexpr int oq = Q + (Q >> 4);
  const int zb = t + (t >> 4);
#pragma unroll
  for (int hb = 0; hb < 2; ++hb) {
    float2 e[4][4];
#pragma unroll
    for (int k = 0; k < 4; ++k) {
      const int K = hb * 4 + k;
      const int C1 = (256 * K) & (Q - 1), Ci = 1024 * K - 3 * C1;
      const int i0 = zb + Ci + (Ci >> 4);
#pragma unroll
      for (int m = 0; m < 4; ++m) e[k][m] = z[i0 + m * oq];
    }
#pragma unroll
    for (int k = 0; k < 4; ++k) {
      const int K = hb * 4 + k;
      const int C1 = (256 * K) & (Q - 1), Ci = 1024 * K - 3 * C1;
      const int i0 = zb + Ci + (Ci >> 4);
      const int mm = (C1 * 16) / H;
      const float rc = W32C[mm], rs = W32S[mm];
      float wx = bwx * rc + bwy * rs, wy = bwy * rc - bwx * rs;
      r4_bfly<INV>(e[k][0], e[k][1], e[k][2], e[k][3], wx, wy);
#pragma unroll
      for (int m = 0; m < 4; ++m) z[i0 + m * oq] = e[k][m];
    }
  }
  __syncthreads();
}
template <bool INV>
DEVI void fft_r4_small(float2* z, int h, float wx, float wy, int t) {
  const int q = h >> 1;
  const int jj = t & (q - 1);
  const int u = 4 * t - 3 * jj;
  float2* z0 = z + (u + (u >> 4));
  const int o1 = q + (q >= 16 ? (q >> 4) : 0);
  const int o2 = 2 * q + (q >= 16 ? (q >> 3) : (q == 8 ? 1 : 0));
  const int o3 = 3 * q + (q >= 16 ? ((3 * q) >> 4) : (q == 8 ? 1 : 0));
#pragma unroll
  for (int hb = 0; hb < 2; ++hb) {
    float2 e[4][4];
#pragma unroll
    for (int k = 0; k < 4; ++k) {
      const int K = hb * 4 + k;
      e[k][0] = z0[1088 * K]; e[k][1] = z0[1088 * K + o1]; e[k][2] = z0[1088 * K + o2]; e[k][3] = z0[1088 * K + o3];
    }
#pragma unroll
    for (int k = 0; k < 4; ++k) {
      const int K = hb * 4 + k;
      r4_bfly<INV>(e[k][0], e[k][1], e[k][2], e[k][3], wx, wy);
      z0[1088 * K] = e[k][0]; z0[1088 * K + o1] = e[k][1]; z0[1088 * K + o2] = e[k][2]; z0[1088 * K + o3] = e[k][3];
    }
  }
  __syncthreads();
}
struct FftTw { float x[5], y[5]; };
DEVI void fft_load_tw(FftTw& f, const float2* __restrict__ tw, int t) {
#pragma unroll
  for (int i = 0; i < 5; ++i) { float2 w = tw[(4096 >> i) + t]; f.x[i] = w.x; f.y[i] = w.y; }
}
DEVI void fft_dif_all(float2* z, const float2* __restrict__ tw, const FftTw& f, int t) {
  float2 wa = tw[256 + (t & 127)], wb = tw[64 + (t & 31)];
  float2 wn = tw[16 + (t & 15)];
  fft_r4_big<4096, false>(z, f.x[0], f.y[0], t);
  fft_r4_big<1024, false>(z, f.x[2], f.y[2], t);
  fft_r4_small<false>(z, 256, wa.x, wa.y, t);
  fft_r4_small<false>(z, 64, wb.x, wb.y, t);
#pragma unroll 1
  for (int h = 16; h >= 1; h >>= 1) {
    float2 w = wn;
    int hn = (h > 1) ? (h >> 1) : 1;
    wn = tw[hn + (t & (hn - 1))];
    fft_stage_small<false>(z, h, w.x, w.y, t);
  }
}
DEVI void fft_dit_all(float2* z, const float2* __restrict__ tw, const FftTw& f, int t) {
  float2 wa = tw[256 + (t & 127)], wb = tw[64 + (t & 31)];
  float2 wn = tw[1];
#pragma unroll 1
  for (int h = 1; h <= 16; h <<= 1) {
    float2 w = wn;
    int hn = (h < 16) ? (h << 1) : 16;
    wn = tw[hn + (t & (hn - 1))];
    fft_stage_small<true>(z, h, w.x, w.y, t);
  }
  fft_r4_small<true>(z, 64, wb.x, wb.y, t);
  fft_r4_small<true>(z, 256, wa.x, wa.y, t);
  fft_r4_big<1024, true>(z, f.x[2], f.y[2], t);
  fft_r4_big<4096, true>(z, f.x[0], f.y[0], t);
}
constexpr float W16C[8] = {1.f, 0.9238795325112867f, 0.7071067811865476f, 0.3826834323650898f, 0.f, -0.3826834323650898f, -0.7071067811865476f, -0.9238795325112867f};
constexpr float W16S[8] = {0.f, 0.3826834323650898f, 0.7071067811865476f, 0.9238795325112867f, 1.f, 0.9238795325112867f, 0.7071067811865476f, 0.3826834323650898f};
DEVI void fft16_dif(float (&xr)[16], float (&xi)[16], const float2* __restrict__ tw) {
#pragma unroll
  for (int hh = 8; hh >= 1; hh >>= 1)
#pragma unroll
    for (int m = 0; m < 8 / hh; ++m)
#pragma unroll
      for (int jj = 0; jj < hh; ++jj) {
        int k = m * 2 * hh + jj;
        const float wx_ = W16C[jj * (8 / hh)], wy_ = -W16S[jj * (8 / hh)];
        float dx = xr[k] - xr[k + hh], dy = xi[k] - xi[k + hh];
        xr[k] += xr[k + hh]; xi[k] += xi[k + hh];
        xr[k + hh] = dx * wx_ - dy * wy_; xi[k + hh] = dx * wy_ + dy * wx_;
      }
}
DEVI void fft16_dit_inv(float (&xr)[16], float (&xi)[16], const float2* __restrict__ tw) {
#pragma unroll
  for (int hh = 1; hh <= 8; hh <<= 1)
#pragma unroll
    for (int m = 0; m < 8 / hh; ++m)
#pragma unroll
      for (int jj = 0; jj < hh; ++jj) {
        int k = m * 2 * hh + jj;
        const float wx_ = W16C[jj * (8 / hh)], wy_ = -W16S[jj * (8 / hh)];
        float px = xr[k + hh] * wx_ + xi[k + hh] * wy_, py = xi[k + hh] * wx_ - xr[k + hh] * wy_;
        float ar = xr[k], ai = xi[k];
        xr[k] = ar + px; xi[k] = ai + py;
        xr[k + hh] = ar - px; xi[k + hh] = ai - py;
      }
}

DEVI void filter_tile(const Params& p, int j, int c, char* lds) {
  float2* z = (float2*)lds;
  float* w3s = (float*)(lds + 69632);
  float* red = w3s + 128;
  const float2* tw = (const float2*)(p.ws + OFF_TW);
  const float* H2 = (const float*)(p.ws + OFF_H2) + (size_t)j * 4096 * 64;
  __half2* HS = (__half2*)(p.ws + OFF_HSPEC);
  int t = tid();
  if (t < 128) w3s[t] = p.hy_fw3[((size_t)j * 64 + (t & 63)) * 2048 + (t >> 6) * 1024 + c];
  __syncthreads();
  const float lo = -3.0701134573253944f, hi = -15.350567286626972f;
  float delta = -(lo + (float)c * ((hi - lo) / 1023.f));
  float asum = 0.f;
#pragma unroll 1
  for (int qq = 0; qq < 16; ++qq) {
    int s = t + 256 * qq;
    const float4* hrow = (const float4*)(H2 + (size_t)s * 64);
    float hf = 0.f, hb = 0.f;
#pragma unroll 4
    for (int i4 = 0; i4 < 16; ++i4) {
      float4 hv = hrow[i4];
      float4 wf = *(const float4*)(w3s + i4 * 4);
      float4 wb = *(const float4*)(w3s + 64 + i4 * 4);
      hf += hv.x * wf.x + hv.y * wf.y + hv.z * wf.z + hv.w * wf.w;
      hb += hv.x * wb.x + hv.y * wb.y + hv.z * wb.z + hv.w * wb.w;
    }
    float tt = (float)s / 4095.f;
    float win = fexp(-tt * delta);
    float vf = hf * win, vb = hb * win;
    z[zi(s)] = make_float2(vf, 0.f);
    asum += fabsf(vf);
    if (s >= 1) { z[zi(8192 - s)] = make_float2(vb, 0.f); asum += fabsf(vb); }
  }
  if (t == 0) z[zi(4096)] = make_float2(0.f, 0.f);
  asum = wave_sum(asum);
  if ((t & 63) == 0) red[t >> 6] = asum;
  __syncthreads();
  float inv = 1.f / (red[0] + red[1] + red[2] + red[3]);
  { FftTw ftw; fft_load_tw(ftw, tw, t); fft_dif_all(z, tw, ftw, t); }
  float bias = p.hy_bias[j * 1024 + c];
  for (int k = t; k < 8192; k += 256) {
    float2 v = z[zi(k)];
    HS[(size_t)c * 8192 + k] = __floats2half2_rn(v.x * inv + bias, v.y * inv);
  }
  __syncthreads();
}

DEVI void layer_prep_phase(const Params& p, int layer, char* lds) {
  if (!(layer & 1)) {
    for (int tile = bid(); tile < 1024 + WT_T_EVEN; tile += gridDim.x) {
      if (tile < 1024) filter_tile(p, layer >> 1, tile, lds);
      else wt_tile(p, layer, tile - 1024, lds);
    }
  } else {
    for (int tile = bid(); tile < WT_T_ODD; tile += gridDim.x) wt_tile(p, layer, tile, lds);
  }
}

DEVI void norm_phase(const Params& p, int layer, int r) {
  int w = tid() >> 6, lane = tid() & 63;
  u16* hn = (u16*)(p.ws + OFF_HN);
  const float* modp = (const float*)(p.ws + OFF_MOD);
  const float* g = p.norm_g + layer * 1024;
  int nw = gridDim.x * 4;
  for (int tok0 = bid() * 4 + w; tok0 < RT; tok0 += 2 * nw) {
    float4 v[2][4]; float ss[2];
#pragma unroll
    for (int u = 0; u < 2; ++u) {
      int tok = min(tok0 + u * nw, RT - 1);
      int sl = tok >> 12, n = tok & 4095, sg = r * 4 + sl;
      const float* x = xsrc_ptr(p, layer, sg) + (size_t)n * D;
      ss[u] = 0.f;
#pragma unroll
      for (int i = 0; i < 4; ++i) { v[u][i] = *(const float4*)(x + i * 256 + lane * 4); ss[u] += v[u][i].x * v[u][i].x + v[u][i].y * v[u][i].y + v[u][i].z * v[u][i].z + v[u][i].w * v[u][i].w; }
    }
#pragma unroll
    for (int o = 32; o >= 1; o >>= 1) { ss[0] += __shfl_xor(ss[0], o); ss[1] += __shfl_xor(ss[1], o); }
#pragma unroll
    for (int u = 0; u < 2; ++u) {
      int tok = tok0 + u * nw;
      if (tok >= RT) break;
      int sl = tok >> 12, sg = r * 4 + sl;
      const float* md = modp + (size_t)(layer * 12 + sg) * 3072;
      float rs = __builtin_amdgcn_rsqf(ss[u] * (1.f / 1024.f) + 1e-6f);
#pragma unroll
      for (int i = 0; i < 4; ++i) {
        int c = i * 256 + lane * 4;
        float4 gg = *(const float4*)(g + c), sh = *(const float4*)(md + c), sc = *(const float4*)(md + 1024 + c);
        float o0 = v[u][i].x * rs * gg.x * (1.f + sc.x) + sh.x;
        float o1 = v[u][i].y * rs * gg.y * (1.f + sc.y) + sh.y;
        float o2 = v[u][i].z * rs * gg.z * (1.f + sc.z) + sh.z;
        float o3 = v[u][i].w * rs * gg.w * (1.f + sc.w) + sh.w;
        uint2 o; o.x = pack2(o0, o1); o.y = pack2(o2, o3);
        *(uint2*)(hn + (size_t)tok * 1024 + c) = o;
      }
    }
  }
}

DEVI void final_phase(const Params& p) {
  int w = tid() >> 6, lane = tid() & 63;
  int nw = gridDim.x * 4;
  const int NT = NSEQ * L;
  for (int tok0 = bid() * 4 + w; tok0 < NT; tok0 += 2 * nw) {
    float4 v[2][4]; float ss[2];
#pragma unroll
    for (int u = 0; u < 2; ++u) {
      int tok = min(tok0 + u * nw, NT - 1);
      const float* x = p.out + (size_t)tok * D;
      ss[u] = 0.f;
#pragma unroll
      for (int i = 0; i < 4; ++i) { v[u][i] = *(const float4*)(x + i * 256 + lane * 4); ss[u] += v[u][i].x * v[u][i].x + v[u][i].y * v[u][i].y + v[u][i].z * v[u][i].z + v[u][i].w * v[u][i].w; }
    }
#pragma unroll
    for (int o = 32; o >= 1; o >>= 1) { ss[0] += __shfl_xor(ss[0], o); ss[1] += __shfl_xor(ss[1], o); }
#pragma unroll
    for (int u = 0; u < 2; ++u) {
      int tok = tok0 + u * nw;
      if (tok >= NT) break;
      float* x = p.out + (size_t)tok * D;
      float rs = __builtin_amdgcn_rsqf(ss[u] * (1.f / 1024.f) + 1e-6f);
#pragma unroll
      for (int i = 0; i < 4; ++i) {
        int c = i * 256 + lane * 4;
        float4 gg = *(const float4*)(p.final_g + c);
        *(float4*)(x + c) = make_float4(v[u][i].x * rs * gg.x, v[u][i].y * rs * gg.y, v[u][i].z * rs * gg.z, v[u][i].w * rs * gg.w);
      }
    }
  }
}

DEVI void gemm_gload(const u16* __restrict__ xg, const u16* __restrict__ yg, int ldx, int ldy, int koff, u32x4 (&rx)[4], u32x4 (&ry)[4]) {
#pragma unroll
  for (int i = 0; i < 4; ++i) {
    rx[i] = *(const u32x4*)(xg + (size_t)(32 * i) * ldx + koff);
    ry[i] = *(const u32x4*)(yg + (size_t)(32 * i) * ldy + koff);
  }
}
DEVI void gemm_swrite(char* st, int lrow, int lch, const u32x4 (&rx)[4], const u32x4 (&ry)[4]) {
#pragma unroll
  for (int i = 0; i < 4; ++i) {
    int off = swz128(lrow + 32 * i, lch);
    *(u32x4*)(st + off) = rx[i]; *(u32x4*)(st + 16384 + off) = ry[i];
  }
}
DEVI void gemm_compute(const char* st, int wr, int wc, int lr, int q, f32x4 (&acc)[4][4]) {
#pragma unroll
  for (int ks = 0; ks < 2; ++ks) {
    bf16x8 xf[4], yf[4];
#pragma unroll
    for (int m = 0; m < 4; ++m) xf[m] = ldsfrag(st, swz128(wr * 64 + m * 16 + lr, ks * 4 + q));
#pragma unroll
    for (int n = 0; n < 4; ++n) yf[n] = ldsfrag(st + 16384, swz128(wc * 64 + n * 16 + lr, ks * 4 + q));
    __builtin_amdgcn_s_setprio(1);
#pragma unroll
    for (int m = 0; m < 4; ++m)
#pragma unroll
      for (int n = 0; n < 4; ++n) acc[m][n] = mfma16(xf[m], yf[n], acc[m][n]);
    __builtin_amdgcn_s_setprio(0);
  }
}
DEVI void gemm_glds_stage(const u16* __restrict__ X, int ldx, const u16* __restrict__ Y, int ldy, int koff, char* st, int w, int lane) {
#pragma unroll
  for (int i = 0; i < 4; ++i) {
    int row = 8 * w + 32 * i + (lane >> 3);
    int chunk = (lane & 7) ^ ((row >> 1) & 7);
    __builtin_amdgcn_global_load_lds((const unsigned*)(X + (size_t)row * ldx + chunk * 8 + koff), (unsigned*)(st + w * 1024 + i * 4096), 16, 0, 0);
    __builtin_amdgcn_global_load_lds((const unsigned*)(Y + (size_t)row * ldy + chunk * 8 + koff), (unsigned*)(st + 16384 + w * 1024 + i * 4096), 16, 0, 0);
  }
}
DEVI void gemm_core(const u16* __restrict__ X, int ldx, const u16* __restrict__ Y, int ldy, int K, f32x4 (&acc)[4][4], char* lds) {
  int t = tid(), w = t >> 6, lane = t & 63, q = lane >> 4, lr = lane & 15;
  int wr = w >> 1, wc = w & 1;
#pragma unroll
  for (int m = 0; m < 4; ++m)
#pragma unroll
    for (int n = 0; n < 4; ++n) acc[m][n] = f32x4{0.f, 0.f, 0.f, 0.f};
  int nk = K >> 6;
  gemm_glds_stage(X, ldx, Y, ldy, 0, lds, w, lane);
  asm volatile("s_waitcnt vmcnt(0)" ::: "memory");
  __syncthreads();
#pragma unroll 1
  for (int kt = 0; kt < nk; ++kt) {
    if (kt + 1 < nk) gemm_glds_stage(X, ldx, Y, ldy, (kt + 1) * 64, lds + ((kt + 1) & 1) * 32768, w, lane);
    gemm_compute(lds + (kt & 1) * 32768, wr, wc, lr, q, acc);
    asm volatile("s_waitcnt vmcnt(0)" ::: "memory");
    __syncthreads();
  }
}

DEVI void gemm_stage_bf16(const f32x4 (&acc)[4][4], char* lds, int wr, int wc, int lr, int q) {
#pragma unroll
  for (int m = 0; m < 4; ++m)
#pragma unroll
    for (int n = 0; n < 4; ++n) {
      int jrow = wc * 64 + n * 16 + lr, i0 = wr * 64 + m * 16 + 4 * q;
      uint2 o; o.x = pack2(acc[m][n][0], acc[m][n][1]); o.y = pack2(acc[m][n][2], acc[m][n][3]);
      *(uint2*)(lds + jrow * 272 + i0 * 2) = o;
    }
  __syncthreads();
}
DEVI void gemm_writeout(const char* lds, u16* dst, size_t pitch, int t) {
#pragma unroll
  for (int it = 0; it < 8; ++it) {
    int e = t + 256 * it; int row = e >> 4, c = e & 15;
    u32x4 v = *(const u32x4*)(lds + row * 272 + c * 16);
    *(u32x4*)(dst + (size_t)row * pitch + c * 8) = v;
  }
  __syncthreads();
}

DEVI void tile_decode(int t, int NT, int& mt, int& nt) {
  int grp = t / (8 * NT), rem = t % (8 * NT);
  nt = rem >> 3; mt = grp * 8 + (rem & 7);
}

DEVI void gemm_evin_phase(const Params& p, int j, char* lds) {
  const u16* A = (const u16*)(p.ws + OFF_HN);
  const u16* W = (const u16*)(p.ws + OFF_WT);
  u16* UT = (u16*)(p.ws + OFF_U);
  u16* US = (u16*)(p.ws + OFF_USSD);
  float* DT = (float*)(p.ws + OFF_DT);
  constexpr int NT = 57, MT = 128;
  int lane = tid() & 63, w = tid() >> 6, q = lane >> 4, lr = lane & 15, wr = w >> 1, wc = w & 1;
  for (int tile = vblock(); tile < MT * NT; tile += gridDim.x) {
    int mt, nt; tile_decode(tile, NT, mt, nt);
    f32x4 acc[4][4];
    const u16* Ap = A + (size_t)mt * 128 * 1024;
    const u16* Wp = W + (size_t)nt * 128 * 1024;
    bool cm = nt < 32;
    gemm_core(cm ? Ap : Wp, 1024, cm ? Wp : Ap, 1024, 1024, acc, lds);
    if (nt < 56) {
      gemm_stage_bf16(acc, lds, wr, wc, lr, q);
      u16* dst = cm ? (UT + ((size_t)(mt >> 5) * 4096 + nt * 128) * 4096 + ((mt * 128) & 4095))
                    : (US + (size_t)(mt * 128) * 3072 + (nt * 128 - 4096));
      gemm_writeout(lds, dst, cm ? 4096 : 3072, tid());
    } else {
#pragma unroll
      for (int m = 0; m < 4; ++m)
#pragma unroll
        for (int n = 0; n < 4; ++n) {
          int col = nt * 128 + wr * 64 + m * 16 + 4 * q;
          int tok = mt * 128 + wc * 64 + n * 16 + lr;
          if (col < 7200) *(float4*)(DT + (size_t)tok * 32 + (col - 7168)) = make_float4(acc[m][n][0], acc[m][n][1], acc[m][n][2], acc[m][n][3]);
        }
    }
  }
}

DEVI void gemm_odin_phase(const Params& p, int j, char* lds) {
  const u16* A = (const u16*)(p.ws + OFF_HN);
  const u16* W = (const u16*)(p.ws + OFF_WT);
  u16* U = (u16*)(p.ws + OFF_U);
  constexpr int NT = 32, MT = 128;
  int lane = tid() & 63, w = tid() >> 6, q = lane >> 4, lr = lane & 15, wr = w >> 1, wc = w & 1;
  for (int tile = vblock(); tile < MT * NT; tile += gridDim.x) {
    int mt, nt; tile_decode(tile, NT, mt, nt);
    f32x4 acc[4][4];
    gemm_core(W + (size_t)nt * 128 * 1024, 1024, A + (size_t)mt * 128 * 1024, 1024, 1024, acc, lds);
    gemm_stage_bf16(acc, lds, wr, wc, lr, q);
    gemm_writeout(lds, U + (size_t)(mt * 128) * 4096 + nt * 128, 4096, tid());
  }
}

DEVI void gemm_out_phase(const Params& p, int layer, int r, char* lds) {
  int j = layer >> 1;
  const u16* A = (const u16*)(p.ws + OFF_MIX);
  const u16* W = (const u16*)(p.ws + OFF_WT) + ((layer & 1) ? WTO_ODOUT : WTO_EVOUT);
  const float* modp = (const float*)(p.ws + OFF_MOD);
  constexpr int NT = 8, MT = 128;
  int lane = tid() & 63, w = tid() >> 6, q = lane >> 4, lr = lane & 15, wr = w >> 1, wc = w & 1;
  for (int tile = vblock(); tile < MT * NT; tile += gridDim.x) {
    int mt, nt; tile_decode(tile, NT, mt, nt);
    f32x4 acc[4][4];
    gemm_core(W + (size_t)nt * 128 * 2048, 2048, A + (size_t)mt * 128 * 2048, 2048, 2048, acc, lds);
    int sl = mt >> 5, sg = r * 4 + sl;
    const float* xs = xsrc_ptr(p, layer, sg);
    float* xo = p.out + (size_t)sg * L * D;
    const float* gate = modp + (size_t)(layer * 12 + sg) * 3072 + 2048;
#pragma unroll
    for (int m = 0; m < 4; ++m)
#pragma unroll
      for (int n = 0; n < 4; ++n) {
        int col = nt * 128 + wr * 64 + m * 16 + 4 * q;
        int tok = (mt * 128 + wc * 64 + n * 16 + lr) & 4095;
        float4 xv = *(const float4*)(xs + (size_t)tok * D + col);
        float4 gv = *(const float4*)(gate + col);
        float4 o = make_float4(xv.x + gv.x * acc[m][n][0], xv.y + gv.y * acc[m][n][1], xv.z + gv.z * acc[m][n][2], xv.w + gv.w * acc[m][n][3]);
        *(float4*)(xo + (size_t)tok * D + col) = o;
      }
  }
}

DEVI void hyena_tile(const Params& p, int j, int tile, char* lds) {
  int c = tile >> 1, pr = tile & 1;
  float2* z = (float2*)lds;
  float* zf = (float*)lds;
  const float2* tw = (const float2*)(p.ws + OFF_TW);
  const __half2* HS = (const __half2*)(p.ws + OFF_HSPEC) + (size_t)c * 8192;
  u16* UT = (u16*)(p.ws + OFF_U);
  int t = tid();
  const float* cw = p.hy_conv_w + (size_t)j * 3 * 3072;
  const float* cb = p.hy_conv_b + (size_t)j * 3072;
  int n0 = t * 16;
  FftTw ftw; fft_load_tw(ftw, tw, t);
#pragma unroll 1
  for (int s = 0; s < 2; ++s) {
    int sl = pr * 2 + s;
    float vfv[16];
#pragma unroll
    for (int k = 0; k < 16; ++k) vfv[k] = 1.f;
#pragma unroll
    for (int which = 1; which <= 2; ++which) {
      int col = which * 1024 + c;
      const u16* src = UT + ((size_t)sl * 4096 + col) * 4096;
      float raw[18];
      uint4 a = *(const uint4*)(src + n0), b = *(const uint4*)(src + n0 + 8);
      float f0[8], f1[8]; unpack8(a, f0); unpack8(b, f1);
#pragma unroll
      for (int k = 0; k < 8; ++k) { raw[1 + k] = f0[k]; raw[9 + k] = f1[k]; }
      raw[0] = (n0 > 0) ? bf2f(src[n0 - 1]) : 0.f;
      raw[17] = (n0 + 16 < 4096) ? bf2f(src[n0 + 16]) : 0.f;
      float w0 = cw[0 * 3072 + col], w1 = cw[1 * 3072 + col], w2 = cw[2 * 3072 + col], bb = cb[col];
#pragma unroll
      for (int k = 0; k < 16; ++k) vfv[k] *= (bb + w0 * raw[k] + w1 * raw[k + 1] + w2 * raw[k + 2]);
    }
#pragma unroll
    for (int k = 0; k < 16; ++k) zf[(17 * t + k) * 2 + s] = vfv[k];
  }
  for (int k = t; k < 4096; k += 256) z[zi(4096 + k)] = make_float2(0.f, 0.f);
  __syncthreads();
  fft_dif_all(z, tw, ftw, t);
  for (int k = t; k < 8192; k += 256) {
    float2 v = z[zi(k)], h = __half22float2(HS[k]);
    z[zi(k)] = make_float2(v.x * h.x - v.y * h.y, v.x * h.y + v.y * h.x);
  }
  __syncthreads();
  fft_dit_all(z, tw, ftw, t);
#pragma unroll 1
  for (int s = 0; s < 2; ++s) {
    int sl = pr * 2 + s;
    const u16* src = UT + ((size_t)sl * 4096 + c) * 4096;
    const u16* gsrc = UT + ((size_t)sl * 4096 + 3072 + c) * 4096;
    u16* dst = UT + ((size_t)sl * 4096 + 2048 + c) * 4096;
    float raw[18];
    uint4 a = *(const uint4*)(src + n0), b = *(const uint4*)(src + n0 + 8);
    float f0[8], f1[8]; unpack8(a, f0); unpack8(b, f1);
#pragma unroll
    for (int k = 0; k < 8; ++k) { raw[1 + k] = f0[k]; raw[9 + k] = f1[k]; }
    raw[0] = (n0 > 0) ? bf2f(src[n0 - 1]) : 0.f;
    raw[17] = (n0 + 16 < 4096) ? bf2f(src[n0 + 16]) : 0.f;
    float w0 = cw[0 * 3072 + c], w1 = cw[1 * 3072 + c], w2 = cw[2 * 3072 + c], bb = cb[c];
    uint4 ga = *(const uint4*)(gsrc + n0), gb = *(const uint4*)(gsrc + n0 + 8);
    float g0[8], g1[8]; unpack8(ga, g0); unpack8(gb, g1);
    float o0[8], o1[8];
#pragma unroll
    for (int k = 0; k < 8; ++k) {
      float x0 = bb + w0 * raw[k] + w1 * raw[k + 1] + w2 * raw[k + 2];
      float y = zf[(17 * t + k) * 2 + s] * (1.f / 8192.f);
      o0[k] = x0 * y * silu_f(g0[k]);
      float x0b = bb + w0 * raw[k + 8] + w1 * raw[k + 9] + w2 * raw[k + 10];
      float yb = zf[(17 * t + k + 8) * 2 + s] * (1.f / 8192.f);
      o1[k] = x0b * yb * silu_f(g1[k]);
    }
    *(uint4*)(dst + n0) = pack8(o0);
    *(uint4*)(dst + n0 + 8) = pack8(o1);
  }
  __syncthreads();
}

template <int NR, bool SILU>
DEVI void conv4_run(const u16* __restrict__ U, int ld, int col, int nb, const float* __restrict__ cw, const float* __restrict__ cb, int cidx, int cwld,
                    float (&out)[NR][8]) {
  float bias[8];
  {
    float4 b0 = *(const float4*)(cb + cidx), b1 = *(const float4*)(cb + cidx + 4);
    bias[0] = b0.x; bias[1] = b0.y; bias[2] = b0.z; bias[3] = b0.w; bias[4] = b1.x; bias[5] = b1.y; bias[6] = b1.z; bias[7] = b1.w;
  }
#pragma unroll
  for (int i = 0; i < NR; ++i)
#pragma unroll
    for (int e = 0; e < 8; ++e) out[i][e] = bias[e];
#pragma unroll
  for (int rr = 0; rr < NR + 3; ++rr) {
    int n = nb - 2 + rr;
    float f[8];
    if (n >= 0 && n < 4096) { uint4 v = *(const uint4*)(U + (size_t)n * ld + col); unpack8(v, f); }
    else {
#pragma unroll
      for (int e = 0; e < 8; ++e) f[e] = 0.f;
    }
#pragma unroll
    for (int k = 0; k < 4; ++k) {
      int i = rr - k;
      if (i >= 0 && i < NR) {
        float4 w0 = *(const float4*)(cw + (size_t)k * cwld + cidx), w1 = *(const float4*)(cw + (size_t)k * cwld + cidx + 4);
        out[i][0] += w0.x * f[0]; out[i][1] += w0.y * f[1]; out[i][2] += w0.z * f[2]; out[i][3] += w0.w * f[3];
        out[i][4] += w1.x * f[4]; out[i][5] += w1.y * f[5]; out[i][6] += w1.z * f[6]; out[i][7] += w1.w * f[7];
      }
    }
  }
  if (SILU) {
#pragma unroll
    for (int i = 0; i < NR; ++i)
#pragma unroll
      for (int e = 0; e < 8; ++e) out[i][e] = silu_f(out[i][e]);
  }
}

DEVI void act_phase(const Params& p, int layer) {
  int j = layer >> 1; bool odd = layer & 1;
  u16* XA = (u16*)(p.ws + OFF_XACT);
  const u16* Ub = (const u16*)(p.ws + (odd ? OFF_U : OFF_USSD));
  int ld = odd ? 4096 : 3072, cbase = odd ? 0 : 1024;
  const float* cw = (odd ? p.lru_conv_w : p.ssd_conv_w) + (size_t)j * 4 * 2048;
  const float* cb = (odd ? p.lru_conv_b : p.ssd_conv_b) + (size_t)j * 2048;
  int total = 256 * (RT / 8);
  for (int e = bid() * 256 + tid(); e < total; e += gridDim.x * 256) {
    int ch8 = e & 255, run = e >> 8;
    int tok0 = run * 8, sl = tok0 >> 12, nb = tok0 & 4095;
    float o[8][8];
    if (odd) conv4_run<8, false>(Ub + (size_t)sl * 4096 * ld, ld, cbase + ch8 * 8, nb, cw, cb, ch8 * 8, 2048, o);
    else conv4_run<8, true>(Ub + (size_t)sl * 4096 * ld, ld, cbase + ch8 * 8, nb, cw, cb, ch8 * 8, 2048, o);
#pragma unroll
    for (int i = 0; i < 8; ++i) *(uint4*)(XA + (size_t)(tok0 + i) * 2048 + ch8 * 8) = pack8(o[i]);
  }
}

DEVI void ssd_gload(const u16* __restrict__ XA, const float* __restrict__ DTR, int n0, int g, int hd, int dir, int t, u32x4 (&rc)[4], u32x4 (&rb)[4], u32x4 (&rxs)[2], float& dtraw) {
#pragma unroll
  for (int i = 0; i < 4; ++i) {
    int row = 2 * (t & 15) + (i & 1) + 32 * (i >> 1), ch8 = t >> 4;
    const u16* src = XA + (size_t)(n0 + row) * 2048 + g * 128 + ch8 * 8;
    rc[i] = *(const u32x4*)(src + 1536);
    rb[i] = *(const u32x4*)(src + 1024);
  }
#pragma unroll
  for (int i = 0; i < 2; ++i) {
    int row = 2 * (t & 15) + i + 32 * (t >> 7), c8 = (t >> 4) & 7;
    rxs[i] = *(const u32x4*)(XA + (size_t)(n0 + row) * 2048 + hd * 64 + c8 * 8);
  }
  int lane = t & 63;
  int n = dir ? (n0 + 63 - lane) : (n0 + lane);
  dtraw = DTR[(size_t)n * 32 + dir * 16 + hd];
}

DEVI void ssd_tile(const Params& p, int j, int tile, char* lds) {
  int sl = tile >> 5, hd = (tile >> 1) & 15, dir = tile & 1;
  int g = hd >> 2;
  const u16* XA = (const u16*)(p.ws + OFF_XACT) + (size_t)sl * 4096 * 2048;
  const float* DTR = (const float*)(p.ws + OFF_DT) + (size_t)sl * 4096 * 32;
  u16* Yo = (u16*)(p.ws + (dir ? OFF_YB : OFF_YF)) + (size_t)sl * 4096 * 1024;
  char* Cs = lds; char* Bs = lds + 16384; char* BTs = lds + 32768; char* XTs = lds + 49152; char* Sb = lds + 57344;
  float* sm = (float*)(lds + 73728);
  int t = tid(), w = t >> 6, lane = t & 63, q = lane >> 4, lr = lane & 15, wi = w >> 1, wj = w & 1;
  float dtb = p.ssd_dt_bias[(j * 2 + dir) * 16 + hd];
  float aneg = -fexp(p.ssd_A_log[(j * 2 + dir) * 16 + hd]);
  f32x4 Sacc[4][2];
#pragma unroll
  for (int a = 0; a < 4; ++a)
#pragma unroll
    for (int b = 0; b < 2; ++b) Sacc[a][b] = f32x4{0.f, 0.f, 0.f, 0.f};
  for (int e = t; e < 1024; e += 256) *(uint4*)(Sb + e * 16) = make_uint4(0, 0, 0, 0);
  u32x4 rc[4], rb[4], rxs[2]; float dtraw;
  ssd_gload(XA, DTR, dir ? (4096 - 64) : 0, g, hd, dir, t, rc, rb, rxs, dtraw);

#pragma unroll 1
  for (int cc = 0; cc < 64; ++cc) {
    int par = cc & 1;
    float* dts = sm + par * 64; float* acum = sm + 128 + par * 64;
    int n0 = dir ? (4096 - 64 * (cc + 1)) : 64 * cc;
    if (w == 0) {
      float dtv = softplus_f(dtraw + dtb);
      float x = dtv * aneg;
#pragma unroll
      for (int o = 1; o < 64; o <<= 1) { float v = __shfl_up(x, o); if (lane >= o) x += v; }
      dts[lane] = dtv; acum[lane] = x;
    }
    lds_barrier();
    float alast = acum[63];
    {
      int ch8 = t >> 4, rl = t & 15;
#pragma unroll
      for (int pr = 0; pr < 2; ++pr) {
        int row0 = 2 * rl + 32 * pr;
        int le = dir ? (62 - row0) : row0;
        u32x4 ce = dir ? rc[2 * pr + 1] : rc[2 * pr], co = dir ? rc[2 * pr] : rc[2 * pr + 1];
        u32x4 be = dir ? rb[2 * pr + 1] : rb[2 * pr], bo = dir ? rb[2 * pr] : rb[2 * pr + 1];
        *(u32x4*)(Cs + swz256(le, ch8)) = ce; *(u32x4*)(Cs + swz256(le + 1, ch8)) = co;
        *(u32x4*)(Bs + swz256(le, ch8)) = be; *(u32x4*)(Bs + swz256(le + 1, ch8)) = bo;
        float fe[8], fo[8]; unpack8v(be, fe); unpack8v(bo, fo);
        float de = fexp(alast - acum[le]), dod = fexp(alast - acum[le + 1]);
        char* bt = BTs + (le & 7) * 2;
#pragma unroll
        for (int e2 = 0; e2 < 8; ++e2) {
          int nn = ch8 * 8 + e2;
          *(unsigned*)(bt + swz128(nn, le >> 3)) = pack2(fe[e2] * de, fo[e2] * dod);
        }
      }
    }
    {
      int c8 = (t >> 4) & 7, rl = t & 15;
      int row0 = 2 * rl + 32 * (t >> 7);
      int le = dir ? (62 - row0) : row0;
      u32x4 xe = dir ? rxs[1] : rxs[0], xo = dir ? rxs[0] : rxs[1];
      float fe[8], fo[8]; unpack8v(xe, fe); unpack8v(xo, fo);
      float de = dts[le], dod = dts[le + 1];
      char* xt = XTs + (le & 7) * 2;
#pragma unroll
      for (int e2 = 0; e2 < 8; ++e2) {
        int pp = c8 * 8 + e2;
        *(unsigned*)(xt + swz128(pp, le >> 3)) = pack2(fe[e2] * de, fo[e2] * dod);
      }
    }
    { int cn = min(cc + 1, 63); ssd_gload(XA, DTR, dir ? (4096 - 64 * (cn + 1)) : 64 * cn, g, hd, dir, t, rc, rb, rxs, dtraw); }
    __builtin_amdgcn_sched_barrier(0);
    lds_barrier();
    f32x4 aoff[2][2], cbm[2][2];
#pragma unroll
    for (int m = 0; m < 2; ++m)
#pragma unroll
      for (int n = 0; n < 2; ++n) { aoff[m][n] = f32x4{0.f, 0.f, 0.f, 0.f}; cbm[m][n] = f32x4{0.f, 0.f, 0.f, 0.f}; }
#pragma unroll
    for (int ks = 0; ks < 4; ++ks) {
      bf16x8 sf[2], bf[2], cf[2];
#pragma unroll
      for (int m = 0; m < 2; ++m) {
        int row = (2 * wi + m) * 16 + lr;
        sf[m] = ldsfrag(Sb, swz256(row, ks * 4 + q));
        bf[m] = ldsfrag(Bs, swz256(row, ks * 4 + q));
      }
#pragma unroll
      for (int n = 0; n < 2; ++n) cf[n] = ldsfrag(Cs, swz256((2 * wj + n) * 16 + lr, ks * 4 + q));
#pragma unroll
      for (int m = 0; m < 2; ++m)
#pragma unroll
        for (int n = 0; n < 2; ++n) { aoff[m][n] = mfma16(sf[m], cf[n], aoff[m][n]); cbm[m][n] = mfma16(bf[m], cf[n], cbm[m][n]); }
    }
    lds_barrier();
    char* Ms = Bs;
#pragma unroll
    for (int m = 0; m < 2; ++m)
#pragma unroll
      for (int n = 0; n < 2; ++n) {
        int l = (2 * wj + n) * 16 + lr; int s0 = (2 * wi + m) * 16 + 4 * q;
        float al = acum[l];
        float v[4];
#pragma unroll
        for (int rg = 0; rg < 4; ++rg) { int s = s0 + rg; v[rg] = (l >= s) ? cbm[m][n][rg] * fexp(al - acum[s]) : 0.f; }
        uint2 o; o.x = pack2(v[0], v[1]); o.y = pack2(v[2], v[3]);
        *(uint2*)(Ms + swz128(l, s0 >> 3) + (s0 & 7) * 2) = o;
      }
    lds_barrier();
    f32x4 adg[2][2];
#pragma unroll
    for (int m = 0; m < 2; ++m)
#pragma unroll
      for (int n = 0; n < 2; ++n) adg[m][n] = f32x4{0.f, 0.f, 0.f, 0.f};
    float cdec = fexp(alast);
#pragma unroll
    for (int a = 0; a < 4; ++a)
#pragma unroll
      for (int b = 0; b < 2; ++b) { Sacc[a][b][0] *= cdec; Sacc[a][b][1] *= cdec; Sacc[a][b][2] *= cdec; Sacc[a][b][3] *= cdec; }
#pragma unroll
    for (int ks = 0; ks < 2; ++ks) {
      bf16x8 xf[2], mf[2], btf[4], xyf[2];
#pragma unroll
      for (int m = 0; m < 2; ++m) xf[m] = ldsfrag(XTs, swz128((2 * wi + m) * 16 + lr, ks * 4 + q));
#pragma unroll
      for (int n = 0; n < 2; ++n) mf[n] = ldsfrag(Ms, swz128((2 * wj + n) * 16 + lr, ks * 4 + q));
#pragma unroll
      for (int m = 0; m < 2; ++m)
#pragma unroll
        for (int n = 0; n < 2; ++n) adg[m][n] = mfma16(xf[m], mf[n], adg[m][n]);
#pragma unroll
      for (int a = 0; a < 4; ++a) btf[a] = ldsfrag(BTs, swz128((4 * wi + a) * 16 + lr, ks * 4 + q));
#pragma unroll
      for (int b = 0; b < 2; ++b) xyf[b] = ldsfrag(XTs, swz128((2 * wj + b) * 16 + lr, ks * 4 + q));
#pragma unroll
      for (int a = 0; a < 4; ++a)
#pragma unroll
        for (int b = 0; b < 2; ++b) Sacc[a][b] = mfma16(btf[a], xyf[b], Sacc[a][b]);
    }
#pragma unroll
    for (int m = 0; m < 2; ++m)
#pragma unroll
      for (int n = 0; n < 2; ++n) {
        int l = (2 * wj + n) * 16 + lr; int p0 = (2 * wi + m) * 16 + 4 * q;
        float e = fexp(acum[l]);
        int ntok = dir ? (n0 + 63 - l) : (n0 + l);
        uint2 o; o.x = pack2(adg[m][n][0] + e * aoff[m][n][0], adg[m][n][1] + e * aoff[m][n][1]);
        o.y = pack2(adg[m][n][2] + e * aoff[m][n][2], adg[m][n][3] + e * aoff[m][n][3]);
        *(uint2*)(Yo + (size_t)ntok * 1024 + hd * 64 + p0) = o;
      }
#pragma unroll
    for (int a = 0; a < 4; ++a)
#pragma unroll
      for (int b = 0; b < 2; ++b) {
        int pc = (2 * wj + b) * 16 + lr; int nn0 = (4 * wi + a) * 16 + 4 * q;
        uint2 o; o.x = pack2(Sacc[a][b][0], Sacc[a][b][1]); o.y = pack2(Sacc[a][b][2], Sacc[a][b][3]);
        *(uint2*)(Sb + swz256(pc, nn0 >> 3) + (nn0 & 7) * 2) = o;
      }
  }
  __syncthreads();
}

DEVI void even_mixer_phase(const Params& p, int j, char* lds) {
  int nb = gridDim.x, b = bid();
  if (nb == 512) {
    if (b < 128) ssd_tile(p, j, b, lds);
    else { for (int k = b - 128; k < 2048; k += 384) hyena_tile(p, j, k, lds); }
  } else {
    for (int tile = b; tile < 128 + 2048; tile += nb) {
      if (tile < 128) ssd_tile(p, j, tile, lds);
      else hyena_tile(p, j, tile - 128, lds);
    }
  }
}

DEVI void even_final_phase(const Params& p, int j, char* lds) {
  int t = tid(), w = t >> 6, lane = t & 63;
  const u16* US = (const u16*)(p.ws + OFF_USSD);
  const u16* YF = (const u16*)(p.ws + OFF_YF);
  const u16* YB = (const u16*)(p.ws + OFF_YB);
  const u16* UT = (const u16*)(p.ws + OFF_U);
  const u16* XA = (const u16*)(p.ws + OFF_XACT);
  u16* MIX = (u16*)(p.ws + OFF_MIX);
  constexpr int T_SSD = RT / 16;
  constexpr int T_HY = RS * 64 * 16;
  for (int tile = bid(); tile < T_SSD + T_HY; tile += gridDim.x) {
    if (tile < T_SSD) {
#pragma unroll 1
      for (int tk = w; tk < 16; tk += 4) {
        int tok = tile * 16 + tk;
        uint2 xr[4], yf[4], yb[4], zz[4];
#pragma unroll
        for (int g = 0; g < 4; ++g) {
          int ch = g * 256 + lane * 4;
          xr[g] = *(const uint2*)(XA + (size_t)tok * 2048 + ch);
          yf[g] = *(const uint2*)(YF + (size_t)tok * 1024 + ch);
          yb[g] = *(const uint2*)(YB + (size_t)tok * 1024 + ch);
          zz[g] = *(const uint2*)(US + (size_t)tok * 3072 + ch);
        }
        float y[4][4], ss[4];
#pragma unroll
        for (int g = 0; g < 4; ++g) {
          int ch = g * 256 + lane * 4;
          float dsk = p.ssd_D[j * 16 + (ch >> 6)];
          y[g][0] = (bflo(yf[g].x) + bflo(yb[g].x) + bflo(xr[g].x) * dsk) * silu_f(bflo(zz[g].x));
          y[g][1] = (bfhi(yf[g].x) + bfhi(yb[g].x) + bfhi(xr[g].x) * dsk) * silu_f(bfhi(zz[g].x));
          y[g][2] = (bflo(yf[g].y) + bflo(yb[g].y) + bflo(xr[g].y) * dsk) * silu_f(bflo(zz[g].y));
          y[g][3] = (bfhi(yf[g].y) + bfhi(yb[g].y) + bfhi(xr[g].y) * dsk) * silu_f(bfhi(zz[g].y));
          ss[g] = y[g][0] * y[g][0] + y[g][1] * y[g][1] + y[g][2] * y[g][2] + y[g][3] * y[g][3];
        }
#pragma unroll
        for (int o = 32; o >= 1; o >>= 1) {
#pragma unroll
          for (int g = 0; g < 4; ++g) ss[g] += __shfl_xor(ss[g], o);
        }
#pragma unroll
        for (int g = 0; g < 4; ++g) {
          int ch = g * 256 + lane * 4;
          float rs = __builtin_amdgcn_rsqf(ss[g] * (1.f / 256.f) + 1e-5f);
          float4 ng = *(const float4*)(p.ssd_norm_g + j * 1024 + ch);
          uint2 o; o.x = pack2(y[g][0] * rs * ng.x, y[g][1] * rs * ng.y); o.y = pack2(y[g][2] * rs * ng.z, y[g][3] * rs * ng.w);
          *(uint2*)(MIX + (size_t)tok * 2048 + 1024 + ch) = o;
        }
      }
    } else {
      int tt = tile - T_SSD;
      int sl = tt >> 10, tb = (tt >> 4) & 63, cbk = tt & 15;
      u16* ts = (u16*)lds;
#pragma unroll
      for (int i = 0; i < 2; ++i) {
        int e = t + 256 * i; int c = e >> 3, n8 = e & 7;
        uint4 v = *(const uint4*)(UT + ((size_t)sl * 4096 + 2048 + cbk * 64 + c) * 4096 + tb * 64 + n8 * 8);
        *(uint4*)(ts + c * 72 + n8 * 8) = v;
      }
      __syncthreads();
#pragma unroll
      for (int i = 0; i < 2; ++i) {
        int e = t + 256 * i; int n = e >> 3, c8 = e & 7;
        unsigned wv[4];
#pragma unroll
        for (int k = 0; k < 4; ++k) wv[k] = (unsigned)ts[(c8 * 8 + 2 * k) * 72 + n] | ((unsigned)ts[(c8 * 8 + 2 * k + 1) * 72 + n] << 16);
        *(uint4*)(MIX + ((size_t)sl * 4096 + tb * 64 + n) * 2048 + cbk * 64 + c8 * 8) = make_uint4(wv[0], wv[1], wv[2], wv[3]);
      }
      __syncthreads();
    }
  }
}

DEVI void lru_tile(const Params& p, int j, int tile, char* lds) {
  constexpr int CT = 64;
  constexpr int NCH = 4096 / CT;
  int sl = tile >> 6, h = (tile >> 2) & 15, dir = (tile >> 1) & 1, hf2 = tile & 1;
  const u16* XA = (const u16*)(p.ws + OFF_XACT) + (size_t)sl * 4096 * 2048;
  u16* Ho = (u16*)(p.ws + (dir ? OFF_HB : OFF_HF)) + (size_t)sl * 4096 * 2048;
  int t = tid(), w = t >> 6, lane = t & 63, q = lane >> 4, lr = lane & 15;
  char* Xs0 = lds;
  float* As = (float*)(lds + 32768 + w * 10240);
  float* Us = As + CT * 20;
  const u16* Wa = (const u16*)(p.ws + OFF_WT) + WTO_LRU + ((size_t)((dir * 2 + 0) * 16 + h)) * 16384;
  const u16* Wx = (const u16*)(p.ws + OFF_WT) + WTO_LRU + ((size_t)((dir * 2 + 1) * 16 + h)) * 16384;
  bf16x8 wa[4], wx[4];
#pragma unroll
  for (int ks = 0; ks < 4; ++ks) {
    int row = 64 * hf2 + w * 16 + lr;
    wa[ks] = *(const bf16x8*)(Wa + row * 128 + ks * 32 + q * 8);
    wx[ks] = *(const bf16x8*)(Wx + row * 128 + ks * 32 + q * 8);
  }
  float ba[4], bx[4], ls[4];
#pragma unroll
  for (int rg = 0; rg < 4; ++rg) {
    int n = 64 * hf2 + w * 16 + 4 * q + rg;
    int cidx = (j * 2 + dir) * 2048 + h * 128 + n;
    ba[rg] = -1.4426950408889634f * p.lru_b_a[cidx]; bx[rg] = -1.4426950408889634f * p.lru_b_x[cidx];
    ls[rg] = -8.f * 1.4426950408889634f * softplus_f(-p.lru_lam[cidx]);
  }
  float hstate = 0.f;
  u32x4 r0[4], r1[4];
#define LRU_LOAD(R, TILE) do { int _cn = min((TILE), NCH - 1); int _n1 = dir ? (4096 - CT * (_cn + 1)) : CT * _cn; \
    _Pragma("unroll") for (int i = 0; i < 4; ++i) { int e = t + 256 * i; R[i] = *(const u32x4*)(XA + (size_t)(_n1 + (e >> 4)) * 2048 + h * 128 + (e & 15) * 8); } } while (0)
  {
    int n0 = dir ? (4096 - CT) : 0;
#pragma unroll
    for (int i = 0; i < 4; ++i) {
      int e = t + 256 * i; int row = e >> 4, ch8 = e & 15;
      u32x4 v = *(const u32x4*)(XA + (size_t)(n0 + row) * 2048 + h * 128 + ch8 * 8);
      int l = dir ? (CT - 1 - row) : row;
      *(u32x4*)(Xs0 + swz256(l, ch8)) = v;
    }
    LRU_LOAD(r1, 1); LRU_LOAD(r0, 2);
  }
  lds_barrier();
#define LRU_CHUNK(CC, R) do {                                                                              \
    const int cc = (CC);                                                                                   \
    char* Xs = Xs0 + (cc & 1) * 16384;                                                                     \
    char* Xn = Xs0 + ((cc + 1) & 1) * 16384;                                                               \
    _Pragma("unroll") for (int i = 0; i < 4; ++i) {                                                        \
      int e = t + 256 * i; int row = e >> 4, ch8 = e & 15;                                                 \
      int l = dir ? (CT - 1 - row) : row;                                                                  \
      *(u32x4*)(Xn + swz256(l, ch8)) = R[i];                                                               \
    }                                                                                                      \
    LRU_LOAD(R, cc + 3);                                                                                   \
    __builtin_amdgcn_sched_barrier(0);                                                                     \
    _Pragma("unroll") for (int jh = 0; jh < 2; ++jh) {                                                     \
      f32x4 aa[2], ax[2];                                                                                  \
      _Pragma("unroll") for (int jt = 0; jt < 2; ++jt) { aa[jt] = f32x4{0.f, 0.f, 0.f, 0.f}; ax[jt] = f32x4{0.f, 0.f, 0.f, 0.f}; } \
      _Pragma("unroll") for (int ks = 0; ks < 4; ++ks) {                                                   \
        _Pragma("unroll") for (int jt = 0; jt < 2; ++jt) {                                                 \
          bf16x8 yf = ldsfrag(Xs, swz256((jh * 2 + jt) * 16 + lr, ks * 4 + q));                            \
          aa[jt] = mfma16(wa[ks], yf, aa[jt]); ax[jt] = mfma16(wx[ks], yf, ax[jt]);                        \
        }                                                                                                  \
      }                                                                                                    \
      _Pragma("unroll") for (int jt = 0; jt < 2; ++jt) {                                                   \
        int tok = (jh * 2 + jt) * 16 + lr; int nc = 64 * hf2 + w * 16 + 4 * q;                             \
        uint2 xr = *(const uint2*)(Xs + swz256(tok, nc >> 3) + (nc & 7) * 2);                              \
        float xv[4] = {bflo(xr.x), bfhi(xr.x), bflo(xr.y), bfhi(xr.y)};                                    \
        float av[4], uv[4];                                                                                \
        _Pragma("unroll") for (int rg = 0; rg < 4; ++rg) {                                                 \
          float r = rcp_f(1.f + __builtin_amdgcn_exp2f(fmaf(aa[jt][rg], -1.4426950408889634f, ba[rg])));   \
          float ig = rcp_f(1.f + __builtin_amdgcn_exp2f(fmaf(ax[jt][rg], -1.4426950408889634f, bx[rg])));  \
          float a = __builtin_amdgcn_exp2f(r * ls[rg]);                                                    \
          av[rg] = a;                                                                                      \
          uv[rg] = xv[rg] * ig * __builtin_amdgcn_sqrtf(fmaxf(fmaf(-a, a, 1.f), 0.f));                                      \
        }                                                                                                  \
        *(float4*)(As + tok * 20 + 4 * q) = make_float4(av[0], av[1], av[2], av[3]);                       \
        *(float4*)(Us + tok * 20 + 4 * q) = make_float4(uv[0], uv[1], uv[2], uv[3]);                       \
      }                                                                                                    \
    }                                                                                                      \
    asm volatile("s_waitcnt lgkmcnt(0)" ::: "memory");                                                     \
    {     \
      float hl_[16], pl_[16];                                                                              \
      {                                                                                                    \
        float av_[16], uv_[16];                                                                            \
        _Pragma("unroll") for (int k = 0; k < 16; ++k) { av_[k] = As[(16 * q + k) * 20 + lr]; uv_[k] = Us[(16 * q + k) * 20 + lr]; } \
        float hh = 0.f, pp = 1.f;                                                                          \
        _Pragma("unroll") for (int k = 0; k < 16; ++k) { hh = av_[k] * hh + uv_[k]; pp *= av_[k]; hl_[k] = hh; pl_[k] = pp; } \
      }                                                                                                    \
      float pe0 = __shfl(pl_[15], lr), he0 = __shfl(hl_[15], lr);                                          \
      float pe1 = __shfl(pl_[15], lr + 16), he1 = __shfl(hl_[15], lr + 16);                                \
      float pe2 = __shfl(pl_[15], lr + 32), he2 = __shfl(hl_[15], lr + 32);                                \
      float pe3 = __shfl(pl_[15], lr + 48), he3 = __shfl(hl_[15], lr + 48);                                \
      float c1 = pe0 * hstate + he0, c2 = pe1 * c1 + he1, c3 = pe2 * c2 + he2;                             \
      float cin = (q == 0) ? hstate : (q == 1) ? c1 : (q == 2) ? c2 : c3;                                  \
      hstate = pe3 * c3 + he3;                                                                             \
      _Pragma("unroll") for (int k = 0; k < 16; ++k) As[(16 * q + k) * 20 + lr] = hl_[k] + pl_[k] * cin;     \
    }                                                                                                      \
    asm volatile("s_waitcnt lgkmcnt(0)" ::: "memory");                                                     \
    {                                                        \
      float4 h0 = *(const float4*)(As + lane * 20), h1 = *(const float4*)(As + lane * 20 + 4);             \
      float4 h2 = *(const float4*)(As + lane * 20 + 8), h3 = *(const float4*)(As + lane * 20 + 12);        \
      int n0c = dir ? (4096 - CT * (cc + 1)) : CT * cc;                                                    \
      int ntok = dir ? (n0c + CT - 1 - lane) : (n0c + lane);                                               \
      u32x4 o0, o1;                                                                                        \
      o0[0] = pack2(h0.x, h0.y); o0[1] = pack2(h0.z, h0.w); o0[2] = pack2(h1.x, h1.y); o0[3] = pack2(h1.z, h1.w); \
      o1[0] = pack2(h2.x, h2.y); o1[1] = pack2(h2.z, h2.w); o1[2] = pack2(h3.x, h3.y); o1[3] = pack2(h3.z, h3.w); \
      u16* dst = Ho + (size_t)ntok * 2048 + h * 128 + 64 * hf2 + 16 * w;                                   \
      *(u32x4*)dst = o0; *(u32x4*)(dst + 8) = o1;                                                          \
    }                                                                                                      \
    lds_barrier();                                                                                         \
  } while (0)
#pragma unroll 1
  for (int c2 = 0; c2 < NCH; c2 += 2) {
    LRU_CHUNK(c2 + 0, r1);
    LRU_CHUNK(c2 + 1, r0);
  }
#undef LRU_CHUNK
#undef LRU_LOAD
  __syncthreads();
}

DEVI void lru_phase(const Params& p, int j, char* lds) {
  for (int tile = bid(); tile < 256; tile += gridDim.x) lru_tile(p, j, tile, lds);
}

DEVI void odd_final_phase(const Params& p) {
  const u16* HF = (const u16*)(p.ws + OFF_HF);
  const u16* HB = (const u16*)(p.ws + OFF_HB);
  const u16* U = (const u16*)(p.ws + OFF_U);
  u16* MIX = (u16*)(p.ws + OFF_MIX);
  size_t total = (size_t)RT * 256;
  for (size_t e = (size_t)bid() * 256 + tid(); e < total; e += (size_t)gridDim.x * 256) {
    size_t tok = e >> 8; int c = (int)(e & 255) * 8;
    uint4 a = *(const uint4*)(HF + tok * 2048 + c), b = *(const uint4*)(HB + tok * 2048 + c), gt = *(const uint4*)(U + tok * 4096 + 2048 + c);
    float fa[8], fb[8], fg[8], o[8];
    unpack8(a, fa); unpack8(b, fb); unpack8(gt, fg);
#pragma unroll
    for (int k = 0; k < 8; ++k) o[k] = (fa[k] + fb[k]) * silu_f(fg[k]);
    *(uint4*)(MIX + tok * 2048 + c) = pack8(o);
  }
}

constexpr int NPHASE = 82;
DEVI bool phase_exists(int ph) {
  if (ph == 0 || ph == 81) return true;
  int s = (ph - 1) % 20;
  if (s > 18) return false;
  if (s >= 1 && (s - 1) % 6 == 0) return false;
  return true;
}
DEVI void run_phase(const Params& p, int ph, char* lds) {
  if (ph == 0) { prep_phase(p, lds); return; }
  if (ph == 81) { final_phase(p); return; }
  int q = ph - 1, layer = q / 20, s = q % 20, j = layer >> 1;
  bool odd = layer & 1;
  if (s == 0) { layer_prep_phase(p, layer, lds); norm_phase(p, layer, 0); return; }
  int r = (s - 1) / 6, step = (s - 1) % 6;
  switch (step) {
    case 0: norm_phase(p, layer, r); break;
    case 1: if (odd) gemm_odin_phase(p, j, lds); else gemm_evin_phase(p, j, lds); break;
    case 2: act_phase(p, layer); break;
    case 3: if (odd) lru_phase(p, j, lds); else even_mixer_phase(p, j, lds); break;
    case 4: if (odd) odd_final_phase(p); else even_final_phase(p, j, lds); break;
    case 5: gemm_out_phase(p, layer, r, lds); if (r < NROUND - 1) norm_phase(p, layer, r + 1); break;
  }
}

__global__ void __launch_bounds__(NTHR, 2) fwd_kernel(Params p, int ph0, int ph1) {
  __shared__ __attribute__((aligned(16))) char lds[SMEM_BYTES];
  __shared__ uint4 xb_words;
  cg::grid_group grid = cg::this_grid();
  if (threadIdx.x == 0) xb_words = make_uint4(0u, 0u, 0u, 0u);
  __syncthreads();
  XcdBarrier xb = xcd_barrier_post((unsigned*)(p.ws + OFF_BAR), (volatile LAS unsigned*)&xb_words);
  for (int ph = ph0; ph < ph1; ++ph) {
    if (!phase_exists(ph)) continue;
    run_phase(p, ph, lds);
    if (ph + 1 < ph1) {
      if (ph1 < 0) grid.sync();
      xcd_barrier(xb);
    }
  }
}

extern "C" void kernel_launch(void* const* d_in, const int* in_sizes, int n_in, void* d_out, int out_size, void* d_ws, size_t ws_size,
                              hipStream_t stream) {
  if (ws_size < WS_NEED) { fprintf(stderr, "workspace too small: %zu < %zu\n", ws_size, (size_t)WS_NEED); return; }
  Params p{};
  const float** pp = (const float**)&p;
  for (int i = 0; i < 34; ++i) pp[i] = (const float*)d_in[i];
  p.out = (float*)d_out;
  p.ws = (char*)d_ws;
  static int grid_blocks = 0;
  if (!grid_blocks) {
    int dev = 0, cus = 0, per_cu = 0;
    hipGetDevice(&dev);
    hipDeviceGetAttribute(&cus, hipDeviceAttributeMultiprocessorCount, dev);
    hipOccupancyMaxActiveBlocksPerMultiprocessor(&per_cu, fwd_kernel, NTHR, 0);
    if (per_cu > 2) per_cu = 2;
    if (per_cu < 1) per_cu = 1;
    grid_blocks = cus * per_cu;
  }
  int ph0 = 0, ph1 = NPHASE;
  hipMemsetAsync((char*)d_ws + OFF_BAR, 0, SZ_BAR, stream);
  void* args[] = {&p, &ph0, &ph1};
  hipError_t e = hipLaunchCooperativeKernel((void*)fwd_kernel, dim3(grid_blocks), dim3(NTHR), args, 0, stream);
  if (e != hipSuccess) fprintf(stderr, "cooperative launch failed: %s (grid %d)\n", hipGetErrorString(e), grid_blocks);
}
```

```cpp
#include <hip/hip_runtime.h>
#include <hip/hip_cooperative_groups.h>
#include <hip/hip_fp16.h>
#include <cstdio>
namespace cg = cooperative_groups;

typedef unsigned short u16;
using bf16x8 = __attribute__((ext_vector_type(8))) short;
using f32x4 = __attribute__((ext_vector_type(4))) float;
using u32x4 = __attribute__((ext_vector_type(4))) unsigned int;
#define DEVI __device__ __forceinline__

constexpr int L = 4096, D = 1024, NSEQ = 12, RS = 4, RT = RS * L, NROUND = 3;
constexpr int EV_IN = 7200, EV_NPAD = 7296;
constexpr int NTHR = 256;
constexpr int SMEM_BYTES = 74752;

constexpr size_t OFF_WT = 0;
constexpr size_t SZ_WT = (size_t)EV_NPAD * 1024 * 2 + (size_t)1024 * 2048 * 2;
constexpr size_t WTO_EVOUT = (size_t)EV_NPAD * 1024;
constexpr size_t WTO_ODOUT = (size_t)4096 * 1024;
constexpr size_t WTO_LRU = WTO_ODOUT + (size_t)1024 * 2048;
constexpr size_t OFF_MOD = OFF_WT + SZ_WT;
constexpr size_t SZ_MOD = (size_t)4 * 12 * 3072 * 4;
constexpr size_t OFF_TW = OFF_MOD + SZ_MOD;
constexpr size_t SZ_TW = 8192 * 8;
constexpr size_t OFF_H2 = OFF_TW + SZ_TW;
constexpr size_t SZ_H2 = (size_t)2 * 4096 * 64 * 4;
constexpr size_t OFF_DT = OFF_H2 + SZ_H2;
constexpr size_t SZ_DT = (size_t)RT * 32 * 4;
constexpr size_t OFF_HSPEC = OFF_DT + SZ_DT;
constexpr size_t SZ_HSPEC = (size_t)1024 * 8192 * 4;
constexpr size_t OFF_HN = OFF_HSPEC + SZ_HSPEC;
constexpr size_t SZ_HN = (size_t)RT * 1024 * 2;
constexpr size_t OFF_U = OFF_HN + SZ_HN;
constexpr size_t SZ_U = (size_t)RT * 4096 * 2;
constexpr size_t OFF_U2 = OFF_U + SZ_U;
constexpr size_t SZ_U2 = (size_t)RT * 4096 * 2;
constexpr size_t OFF_XACT = OFF_U2 + SZ_U2;
constexpr size_t SZ_XACT = (size_t)RT * 2048 * 2;
constexpr size_t OFF_MIX = OFF_XACT + SZ_XACT;
constexpr size_t SZ_MIX = (size_t)RT * 2048 * 2;
constexpr size_t OFF_BAR = OFF_MIX + SZ_MIX;
constexpr size_t SZ_BAR = (size_t)3456 * 4;
constexpr size_t WS_NEED = OFF_BAR + 16384;
constexpr size_t OFF_YF = OFF_HN;
constexpr size_t OFF_USSD = OFF_U2;
constexpr size_t OFF_YB = OFF_U2 + (size_t)RT * 3072 * 2;
constexpr size_t OFF_HF = OFF_U2;
constexpr size_t OFF_HB = OFF_U2 + (size_t)RT * 2048 * 2;

#define XB_TMO      128
#define XB_XCNT(j)  (256  + 64 * (j))
#define XB_XSUB(j)  (1280 + 64 * (j))
#define XB_XGEN(j)  (2304 + 64 * (j))
#define XB_TOP      3328
#define XB_TOPGEN   3392
#define XCD_BAR_WORDS 3456
#define XB_SPIN_CAP (1u << 22)
#define LAS __attribute__((address_space(3)))

__device__ __forceinline__ unsigned xb_ld(unsigned* p)              { return __hip_atomic_load(p, __ATOMIC_RELAXED, __HIP_MEMORY_SCOPE_AGENT); }
__device__ __forceinline__ unsigned xb_add(unsigned* p, unsigned v) { return __hip_atomic_fetch_add(p, v, __ATOMIC_RELAXED, __HIP_MEMORY_SCOPE_AGENT); }
__device__ __forceinline__ unsigned xb_xcc_id() { return (unsigned)__builtin_amdgcn_s_getreg((3 << 11) | 20) & 0xFu; }
#define XB_SPIN(cond, bar) do { unsigned _sp = 0; while (cond) { __builtin_amdgcn_s_sleep(1); \
    if ((++_sp & 255u) == 0u) { if (xb_ld(&(bar)[XB_TMO])) break; if (_sp > XB_SPIN_CAP) { atomicAdd(&(bar)[XB_TMO], 1u); break; } } } } while (0)

struct XcdBarrier {
    unsigned* bar; unsigned x;
    volatile LAS unsigned* st;
};

__device__ __forceinline__ XcdBarrier xcd_barrier_post(unsigned* bar, volatile LAS unsigned* st) {
    XcdBarrier b; b.bar = bar; b.x = xb_xcc_id(); b.st = st;
    if (threadIdx.x == 0) (void)xb_add(&bar[XB_XCNT(b.x)], 1u);
    return b;
}
__device__ __forceinline__ void xcd_barrier_complete(unsigned* bar, unsigned x, unsigned& nloc, unsigned& nx) {
    const unsigned G = gridDim.x * gridDim.y * gridDim.z;
    unsigned sum, cnt, mine, sp = 0u;
    for (;;) {
        sum = 0u; cnt = 0u; mine = 0u;
#pragma unroll
        for (unsigned j = 0; j < 16; ++j) { const unsigned c = xb_ld(&bar[XB_XCNT(j)]); sum += c; cnt += (c > 0u) ? 1u : 0u; mine = (j == x) ? c : mine; }
        if (sum == G) break;
        __builtin_amdgcn_s_sleep(1);
        if ((++sp & 255u) == 0u) { if (xb_ld(&bar[XB_TMO])) break; if (sp > XB_SPIN_CAP) { atomicAdd(&bar[XB_TMO], 1u); break; } }
    }
    nloc = mine > 0u ? mine : 1u; nx = cnt > 0u ? cnt : 1u;
}

__device__ __forceinline__ void xcd_barrier(const XcdBarrier& b) {
    asm volatile("s_waitcnt vmcnt(0)" ::: "memory");
    __syncthreads();
    if (threadIdx.x == 0) {
        unsigned* bar = b.bar;
        __builtin_amdgcn_s_waitcnt(0);
        unsigned nloc = b.st[0], nx = b.st[1];
        if (nloc == 0u) { xcd_barrier_complete(bar, b.x, nloc, nx); b.st[0] = nloc; b.st[1] = nx; }
        const unsigned old = xb_add(&bar[XB_XSUB(b.x)], 1u);
        const unsigned gen = old / nloc;
        if (old + 1u == (gen + 1u) * nloc) {
            __builtin_amdgcn_fence(__ATOMIC_RELEASE, "agent");
            asm volatile("s_waitcnt vmcnt(0)" ::: "memory");
            const unsigned og = xb_add(&bar[XB_TOP], 1u);
            const unsigned tg = og / nx;
            if (og + 1u == (tg + 1u) * nx) xb_add(&bar[XB_TOPGEN], 1u);
            else XB_SPIN(xb_ld(&bar[XB_TOPGEN]) == tg, bar);
            __builtin_amdgcn_fence(__ATOMIC_ACQUIRE, "agent");
            xb_add(&bar[XB_XGEN(b.x)], 1u);
            asm volatile("s_waitcnt vmcnt(0)" ::: "memory");
        } else {
            XB_SPIN(xb_ld(&bar[XB_XGEN(b.x)]) == gen, bar);
            __builtin_amdgcn_fence(__ATOMIC_ACQUIRE, "agent");
            asm volatile("s_waitcnt vmcnt(0)" ::: "memory");
        }
    }
    __syncthreads();
}


struct Params {
  const float *x_prompt, *x_sample, *c_prompt, *c_sample, *mod_w, *mod_b, *norm_g, *final_g;
  const float *ev_w_in, *ev_w_out, *hy_conv_w, *hy_conv_b, *hy_fw1, *hy_fb1, *hy_fw2, *hy_fb2, *hy_fw3, *hy_freq, *hy_bias;
  const float *ssd_conv_w, *ssd_conv_b, *ssd_dt_bias, *ssd_A_log, *ssd_D, *ssd_norm_g;
  const float *od_w_in, *od_w_out, *lru_conv_w, *lru_conv_b, *lru_w_a, *lru_b_a, *lru_w_x, *lru_b_x, *lru_lam;
  float* out;
  char* ws;
};

DEVI unsigned pack2(float a, float b) { unsigned r; asm("v_cvt_pk_bf16_f32 %0, %1, %2" : "=v"(r) : "v"(a), "v"(b)); return r; }
DEVI u16 f2bf(float f) { return (u16)(pack2(f, 0.f) & 0xffffu); }
DEVI float bf2f(u16 h) { return __uint_as_float(((unsigned)h) << 16); }
DEVI float bflo(unsigned w) { return __uint_as_float(w << 16); }
DEVI float bfhi(unsigned w) { return __uint_as_float(w & 0xffff0000u); }
DEVI void unpack8v(u32x4 v, float (&f)[8]) {
  f[0] = bflo(v[0]); f[1] = bfhi(v[0]); f[2] = bflo(v[1]); f[3] = bfhi(v[1]);
  f[4] = bflo(v[2]); f[5] = bfhi(v[2]); f[6] = bflo(v[3]); f[7] = bfhi(v[3]);
}
DEVI void unpack8(uint4 v, float (&f)[8]) {
  f[0] = bflo(v.x); f[1] = bfhi(v.x); f[2] = bflo(v.y); f[3] = bfhi(v.y);
  f[4] = bflo(v.z); f[5] = bfhi(v.z); f[6] = bflo(v.w); f[7] = bfhi(v.w);
}
DEVI uint4 pack8(const float (&f)[8]) {
  uint4 v; v.x = pack2(f[0], f[1]); v.y = pack2(f[2], f[3]); v.z = pack2(f[4], f[5]); v.w = pack2(f[6], f[7]); return v;
}
DEVI float rcp_f(float x) { return __builtin_amdgcn_rcpf(x); }
DEVI float fexp(float x) { return __builtin_amdgcn_exp2f(x * 1.4426950408889634f); }
DEVI float silu_f(float x) { return x * rcp_f(1.f + fexp(-x)); }
DEVI float sigmoid_f(float x) { return rcp_f(1.f + fexp(-x)); }
DEVI float softplus_f(float x) {
  float e = fexp(fminf(x, 30.f));
  float small = e * (1.f - e * (0.5f - e * 0.33333334f));
  float big = __builtin_amdgcn_logf(1.f + e) * 0.6931471805599453f;
  float r = (e < 0.01f) ? small : big;
  return x > 20.f ? x : r;
}
DEVI float sin_f(float x) { return sinpif(x * 0.3183098861837907f); }
DEVI int swz256(int row, int c16) { return row * 256 + ((c16 ^ (row & 15)) << 4); }
DEVI int swz128(int row, int c16) { return row * 128 + ((c16 ^ ((row >> 1) & 7)) << 4); }
DEVI bf16x8 ldsfrag(const char* base, int off) { return *(const bf16x8*)(base + off); }
DEVI f32x4 mfma16(bf16x8 a, bf16x8 b, f32x4 c) { return __builtin_amdgcn_mfma_f32_16x16x32_bf16(a, b, c, 0, 0, 0); }
DEVI float wave_sum(float v) {
#pragma unroll
  for (int o = 32; o >= 1; o >>= 1) v += __shfl_xor(v, o);
  return v;
}
DEVI void lds_barrier() { asm volatile("s_waitcnt lgkmcnt(0)\n\ts_barrier" ::: "memory"); }
DEVI int tid() { int t = threadIdx.x; asm volatile("" : "+v"(t)); return t; }
DEVI int bid() { int b = blockIdx.x; asm volatile("" : "+s"(b)); return b; }
DEVI int vblock() {
  int nb = gridDim.x, b = bid();
  return (nb & 7) ? b : ((b & 7) * (nb >> 3) + (b >> 3));
}
DEVI const float* xsrc_ptr(const Params& p, int layer, int sg) {
  if (layer == 0) return sg < 8 ? p.x_prompt + (size_t)sg * L * D : p.x_sample + (size_t)(sg - 8) * L * D;
  return p.out + (size_t)sg * L * D;
}

DEVI void tconv_tile(const float* src, int K, int N, u16* dst, int kt, int nt, float* lds) {
  int t = tid();
#pragma unroll 4
  for (int i = 0; i < 16; ++i) {
    int e = t + 256 * i; int kk = e >> 6, nn = e & 63; int n = nt * 64 + nn;
    float v = (n < N) ? src[(size_t)(kt * 64 + kk) * N + n] : 0.f;
    lds[nn * 65 + kk] = v;
  }
  __syncthreads();
#pragma unroll
  for (int i = 0; i < 2; ++i) {
    int e = t + 256 * i; int nn = e >> 3, c8 = e & 7;
    float f[8];
#pragma unroll
    for (int k = 0; k < 8; ++k) f[k] = lds[nn * 65 + c8 * 8 + k];
    *(uint4*)(dst + (size_t)(nt * 64 + nn) * K + kt * 64 + c8 * 8) = pack8(f);
  }
  __syncthreads();
}

DEVI void mod_tile(const Params& p, int tile, char* lds) {
  int layer = tile / 48, nchunk = tile % 48;
  int t = tid();
  float* cs = (float*)lds;
  for (int e = t; e < 12288; e += 256) {
    int b = e >> 10, k = e & 1023;
    float c = b < 8 ? p.c_prompt[b * 1024 + k] : p.c_sample[(b - 8) * 1024 + k];
    cs[e] = silu_f(c);
  }
  __syncthreads();
  int nn = t & 63, ks = t >> 6;
  int n = nchunk * 64 + nn;
  float acc[12];
#pragma unroll
  for (int b = 0; b < 12; ++b) acc[b] = 0.f;
  const float* w = p.mod_w + (size_t)layer * 1024 * 3072 + n;
  for (int k = ks * 256; k < ks * 256 + 256; ++k) {
    float wv = w[(size_t)k * 3072];
#pragma unroll
    for (int b = 0; b < 12; ++b) acc[b] += cs[b * 1024 + k] * wv;
  }
  float* red = cs + 12288;
#pragma unroll
  for (int b = 0; b < 12; ++b) red[(ks * 12 + b) * 64 + nn] = acc[b];
  __syncthreads();
  float* modp = (float*)(p.ws + OFF_MOD);
  for (int e = t; e < 768; e += 256) {
    int b = e >> 6, n2 = e & 63;
    float s = red[(0 * 12 + b) * 64 + n2] + red[(1 * 12 + b) * 64 + n2] + red[(2 * 12 + b) * 64 + n2] + red[(3 * 12 + b) * 64 + n2];
    modp[(size_t)(layer * 12 + b) * 3072 + nchunk * 64 + n2] = s + p.mod_b[layer * 3072 + nchunk * 64 + n2];
  }
  __syncthreads();
}

DEVI void h2_tile(const Params& p, int tile, char* lds) {
  int j = tile >> 10, pos0 = (tile & 1023) * 4;
  int t = tid();
  float* zs = (float*)lds;
  float* h1s = zs + 4 * 36;
  if (t < 4 * 33) {
    int pp = t / 33, e = t % 33; int pos = pos0 + pp;
    float val;
    if (e == 0) val = (float)pos / 4095.f;
    else {
      int b = (e - 1) & 15;
      float f = 1e-4f + (float)b * ((15.f - 1e-4f) / 15.f);
      float rev = f * (float)pos * (1.f / 4096.f);
      rev -= floorf(rev);
      float s, c; sincospif(2.f * rev, &s, &c);
      val = (e <= 16) ? c : -s;
    }
    zs[pp * 36 + e] = val;
  }
  __syncthreads();
  int pp = t >> 6, jj = t & 63;
  float fr = p.hy_freq[j * 64 + jj];
  float a = p.hy_fb1[j * 64 + jj];
  for (int e = 0; e < 33; ++e) a += zs[pp * 36 + e] * p.hy_fw1[(j * 33 + e) * 64 + jj];
  h1s[pp * 64 + jj] = sin_f(fr * a);
  __syncthreads();
  a = p.hy_fb2[j * 64 + jj];
  for (int i = 0; i < 64; ++i) a += h1s[pp * 64 + i] * p.hy_fw2[(j * 64 + i) * 64 + jj];
  float* H2 = (float*)(p.ws + OFF_H2);
  H2[((size_t)j * 4096 + pos0 + pp) * 64 + jj] = sin_f(fr * a);
  __syncthreads();
}

constexpr int PREP_T_MOD = 192;
constexpr int PREP_T_TW = 32;
constexpr int PREP_T_H2 = 2048;
constexpr int PREP_TOTAL = PREP_T_MOD + PREP_T_TW + PREP_T_H2;

DEVI void prep_phase(const Params& p, char* lds) {
  for (int tile = bid(); tile < PREP_TOTAL; tile += gridDim.x) {
    int t = tile;
    if (t < PREP_T_MOD) { mod_tile(p, t, lds); continue; }
    t -= PREP_T_MOD;
    if (t < PREP_T_TW) {
      int k = t * 256 + tid();
      int hh = (k == 0) ? 1 : (1 << (31 - __clz(k)));
      int jj = (k == 0) ? 0 : (k - hh);
      float s, c; sincospif((float)jj / (float)hh, &s, &c);
      ((float2*)(p.ws + OFF_TW))[k] = make_float2(c, -s);
      continue;
    }
    t -= PREP_T_TW;
    h2_tile(p, t, lds);
  }
}

constexpr int WT_T_EVIN = 16 * 114, WT_T_EVOUT = 32 * 16, WT_T_EVEN = WT_T_EVIN + WT_T_EVOUT;
constexpr int WT_T_ODIN = 16 * 64, WT_T_ODOUT = 32 * 16, WT_T_LRU = 64 * 4, WT_T_ODD = WT_T_ODIN + WT_T_ODOUT + WT_T_LRU;
DEVI void wt_tile(const Params& p, int layer, int t, char* lds) {
  int j = layer >> 1;
  u16* WT = (u16*)(p.ws + OFF_WT);
  if (!(layer & 1)) {
    if (t < WT_T_EVIN) { tconv_tile(p.ev_w_in + (size_t)j * 1024 * EV_IN, 1024, EV_IN, WT, t % 16, t / 16, (float*)lds); return; }
    t -= WT_T_EVIN;
    tconv_tile(p.ev_w_out + (size_t)j * 2048 * 1024, 2048, 1024, WT + WTO_EVOUT, t % 32, t / 32, (float*)lds);
  } else {
    if (t < WT_T_ODIN) { tconv_tile(p.od_w_in + (size_t)j * 1024 * 4096, 1024, 4096, WT, t % 16, t / 16, (float*)lds); return; }
    t -= WT_T_ODIN;
    if (t < WT_T_ODOUT) { tconv_tile(p.od_w_out + (size_t)j * 2048 * 1024, 2048, 1024, WT + WTO_ODOUT, t % 32, t / 32, (float*)lds); return; }
    t -= WT_T_ODOUT;
    int m = t >> 2, sub = t & 3;
    int dir = m >> 5, gate = (m >> 4) & 1, h = m & 15;
    const float* src = (gate ? p.lru_w_x : p.lru_w_a) + ((size_t)((j * 2 + dir) * 16 + h)) * 16384;
    tconv_tile(src, 128, 128, WT + WTO_LRU + (size_t)m * 16384, sub & 1, sub >> 1, (float*)lds);
  }
}

DEVI int zi(int n) { return n + (n >> 4); }
template <bool INV>
DEVI void bfly_store(float2* z, int i0, int i1, float ax, float ay, float cx, float cy, float wx, float wy) {
  if (!INV) {
    float dx = ax - cx, dy = ay - cy;
    z[i0] = make_float2(ax + cx, ay + cy);
    z[i1] = make_float2(dx * wx - dy * wy, dx * wy + dy * wx);
  } else {
    float px = cx * wx + cy * wy, py = cy * wx - cx * wy;
    z[i0] = make_float2(ax + px, ay + py);
    z[i1] = make_float2(ax - px, ay - py);
  }
}
constexpr float W32C[16] = {1.0000000000f, 0.9807852804f, 0.9238795325f, 0.8314696123f, 0.7071067812f, 0.5555702330f, 0.3826834324f, 0.1950903220f, 0.0000000000f, -0.1950903220f, -0.3826834324f, -0.5555702330f, -0.7071067812f, -0.8314696123f, -0.9238795325f, -0.9807852804f};
constexpr float W32S[16] = {0.0000000000f, 0.1950903220f, 0.3826834324f, 0.5555702330f, 0.7071067812f, 0.8314696123f, 0.9238795325f, 0.9807852804f, 1.0000000000f, 0.9807852804f, 0.9238795325f, 0.8314696123f, 0.7071067812f, 0.5555702330f, 0.3826834324f, 0.1950903220f};
template <int H, bool INV>
DEVI void fft_stage_big(float2* z, float bwx, float bwy, int t) {
  const int zb = t + (t >> 4);
  constexpr int hz = H + (H >> 4);
#pragma unroll
  for (int hb = 0; hb < 2; ++hb) {
    float ax[8], ay[8], cx[8], cy[8];
#pragma unroll
    for (int k = 0; k < 8; ++k) {
      const int K = hb * 8 + k;
      const int C1 = (256 * K) & (H - 1), Ci = 512 * K - C1;
      const int i0 = zb + Ci + (Ci >> 4);
      float2 a = z[i0], c = z[i0 + hz];
      ax[k] = a.x; ay[k] = a.y; cx[k] = c.x; cy[k] = c.y;
    }
#pragma unroll
    for (int k = 0; k < 8; ++k) {
      const int K = hb * 8 + k;
      const int C1 = (256 * K) & (H - 1), Ci = 512 * K - C1;
      const int i0 = zb + Ci + (Ci >> 4);
      const int m = (C1 * 16) / H;
      const float rc = W32C[m], rs = W32S[m];
      float wx = bwx * rc + bwy * rs, wy = bwy * rc - bwx * rs;
      bfly_store<INV>(z, i0, i0 + hz, ax[k], ay[k], cx[k], cy[k], wx, wy);
    }
  }
  __syncthreads();
}
template <bool INV>
DEVI void fft_stage_small(float2* z, int h, float wx, float wy, int t) {
  const int jj = t & (h - 1);
  const int u = 2 * t - jj;
  float2* z0 = z + (u + (u >> 4));
  float2* z1 = z0 + (h + (h >= 16 ? (h >> 4) : 0));
#pragma unroll
  for (int hb = 0; hb < 2; ++hb) {
    float ax[8], ay[8], cx[8], cy[8];
#pragma unroll
    for (int k = 0; k < 8; ++k) {
      const int K = hb * 8 + k;
      float2 a = z0[544 * K], c = z1[544 * K];
      ax[k] = a.x; ay[k] = a.y; cx[k] = c.x; cy[k] = c.y;
    }
#pragma unroll
    for (int k = 0; k < 8; ++k) {
      const int K = hb * 8 + k;
      if (!INV) {
        float dx = ax[k] - cx[k], dy = ay[k] - cy[k];
        z0[544 * K] = make_float2(ax[k] + cx[k], ay[k] + cy[k]);
        z1[544 * K] = make_float2(dx * wx - dy * wy, dx * wy + dy * wx);
      } else {
        float px = cx[k] * wx + cy[k] * wy, py = cy[k] * wx - cx[k] * wy;
        z0[544 * K] = make_float2(ax[k] + px, ay[k] + py);
        z1[544 * K] = make_float2(ax[k] - px, ay[k] - py);
      }
    }
  }
  __syncthreads();
}
template <bool INV>
DEVI void r4_bfly(float2& e0, float2& e1, float2& e2, float2& e3, float w1x, float w1y) {
  float w2x = w1x * w1x - w1y * w1y, w2y = 2.f * w1x * w1y;
  if (!INV) {
    float y0x = e0.x + e2.x, y0y = e0.y + e2.y;
    float dx = e0.x - e2.x, dy = e0.y - e2.y;
    float y2x = dx * w1x - dy * w1y, y2y = dx * w1y + dy * w1x;
    float y1x = e1.x + e3.x, y1y = e1.y + e3.y;
    float ex = e1.x - e3.x, ey = e1.y - e3.y;
    float tx = ex * w1x - ey * w1y, ty = ex * w1y + ey * w1x;
    float y3x = ty, y3y = -tx;
    e0 = make_float2(y0x + y1x, y0y + y1y);
    float fx = y0x - y1x, fy = y0y - y1y;
    e1 = make_float2(fx * w2x - fy * w2y, fx * w2y + fy * w2x);
    e2 = make_float2(y2x + y3x, y2y + y3y);
    float gx = y2x - y3x, gy = y2y - y3y;
    e3 = make_float2(gx * w2x - gy * w2y, gx * w2y + gy * w2x);
  } else {
    float p1x = e1.x * w2x + e1.y * w2y, p1y = e1.y * w2x - e1.x * w2y;
    float p3x = e3.x * w2x + e3.y * w2y, p3y = e3.y * w2x - e3.x * w2y;
    float y0x = e0.x + p1x, y0y = e0.y + p1y, y1x = e0.x - p1x, y1y = e0.y - p1y;
    float y2x = e2.x + p3x, y2y = e2.y + p3y, y3x = e2.x - p3x, y3y = e2.y - p3y;
    float q2x = y2x * w1x + y2y * w1y, q2y = y2y * w1x - y2x * w1y;
    float rx = y3x * w1x + y3y * w1y, ry = y3y * w1x - y3x * w1y;
    float q3x = -ry, q3y = rx;
    e0 = make_float2(y0x + q2x, y0y + q2y);
    e2 = make_float2(y0x - q2x, y0y - q2y);
    e1 = make_float2(y1x + q3x, y1y + q3y);
    e3 = make_float2(y1x - q3x, y1y - q3y);
  }
}
template <int H, bool INV>
DEVI void fft_r4_big(float2* z, float bwx, float bwy, int t) {
  constexpr int Q = H / 2;
  constexpr int oq = Q + (Q >> 4);
  const int zb = t + (t >> 4);
#pragma unroll
  for (int hb = 0; hb < 2; ++hb) {
    float2 e[4][4];
#pragma unroll
    for (int k = 0; k < 4; ++k) {
      const int K = hb * 4 + k;
      const int C1 = (256 * K) & (Q - 1), Ci = 1024 * K - 3 * C1;
      const int i0 = zb + Ci + (Ci >> 4);
#pragma unroll
      for (int m = 0; m < 4; ++m) e[k][m] = z[i0 + m * oq];
    }
#pragma unroll
    for (int k = 0; k < 4; ++k) {
      const int K = hb * 4 + k;
      const int C1 = (256 * K) & (Q - 1), Ci = 1024 * K - 3 * C1;
      const int i0 = zb + Ci + (Ci >> 4);
      const int mm = (C1 * 16) / H;
      const float rc = W32C[mm], rs = W32S[mm];
      float wx = bwx * rc + bwy * rs, wy = bwy * rc - bwx * rs;
      r4_bfly<INV>(e[k][0], e[k][1], e[k][2], e[k][3], wx, wy);
#pragma unroll
      for (int m = 0; m < 4; ++m) z[i0 + m * oq] = e[k][m];
    }
  }
  __syncthreads();
}
template <bool INV>
DEVI void fft_r4_small(float2* z, int h, float wx, float wy, int t) {
  const int q = h >> 1;
  const int jj = t & (q - 1);
  const int u = 4 * t - 3 * jj;
  float2* z0 = z + (u + (u >> 4));
  const int o1 = q + (q >= 16 ? (q >> 4) : 0);
  const int o2 = 2 * q + (q >= 16 ? (q >> 3) : (q == 8 ? 1 : 0));
  const int o3 = 3 * q + (q >= 16 ? ((3 * q) >> 4) : (q == 8 ? 1 : 0));
#pragma unroll
  for (int hb = 0; hb < 2; ++hb) {
    float2 e[4][4];
#pragma unroll
    for (int k = 0; k < 4; ++k) {
      const int K = hb * 4 + k;
      e[k][0] = z0[1088 * K]; e[k][1] = z0[1088 * K + o1]; e[k][2] = z0[1088 * K + o2]; e[k][3] = z0[1088 * K + o3];
    }
#pragma unroll
    for (int k = 0; k < 4; ++k) {
      const int K = hb * 4 + k;
      r4_bfly<INV>(e[k][0], e[k][1], e[k][2], e[k][3], wx, wy);
      z0[1088 * K] = e[k][0]; z0[1088 * K + o1] = e[k][1]; z0[1088 * K + o2] = e[k][2]; z0[1088 * K + o3] = e[k][3];
    }
  }
  __syncthreads();
}
struct FftTw { float x[5], y[5]; };
DEVI void fft_load_tw(FftTw& f, const float2* __restrict__ tw, int t) {
#pragma unroll
  for (int i = 0; i < 5; ++i) { float2 w = tw[(4096 >> i) + t]; f.x[i] = w.x; f.y[i] = w.y; }
}
DEVI void fft_dif_all(float2* z, const float2* __restrict__ tw, const FftTw& f, int t) {
  float2 wa = tw[256 + (t & 127)], wb = tw[64 + (t & 31)];
  float2 wn = tw[16 + (t & 15)];
  fft_r4_big<4096, false>(z, f.x[0], f.y[0], t);
  fft_r4_big<1024, false>(z, f.x[2], f.y[2], t);
  fft_r4_small<false>(z, 256, wa.x, wa.y, t);
  fft_r4_small<false>(z, 64, wb.x, wb.y, t);
#pragma unroll 1
  for (int h = 16; h >= 1; h >>= 1) {
    float2 w = wn;
    int hn = (h > 1) ? (h >> 1) : 1;
    wn = tw[hn + (t & (hn - 1))];
    fft_stage_small<false>(z, h, w.x, w.y, t);
  }
}
DEVI void fft_dit_all(float2* z, const float2* __restrict__ tw, const FftTw& f, int t) {
  float2 wa = tw[256 + (t & 127)], wb = tw[64 + (t & 31)];
  float2 wn = tw[1];
#pragma unroll 1
  for (int h = 1; h <= 16; h <<= 1) {
    float2 w = wn;
    int hn = (h < 16) ? (h << 1) : 16;
    wn = tw[hn + (t & (hn - 1))];
    fft_stage_small<true>(z, h, w.x, w.y, t);
  }
  fft_r4_small<true>(z, 64, wb.x, wb.y, t);
  fft_r4_small<true>(z, 256, wa.x, wa.y, t);
  fft_r4_big<1024, true>(z, f.x[2], f.y[2], t);
  fft_r4_big<4096, true>(z, f.x[0], f.y[0], t);
}
constexpr float W16C[8] = {1.f, 0.9238795325112867f, 0.7071067811865476f, 0.3826834323650898f, 0.f, -0.3826834323650898f, -0.7071067811865476f, -0.9238795325112867f};
constexpr float W16S[8] = {0.f, 0.3826834323650898f, 0.7071067811865476f, 0.9238795325112867f, 1.f, 0.9238795325112867f, 0.7071067811865476f, 0.3826834323650898f};
DEVI void fft16_dif(float (&xr)[16], float (&xi)[16], const float2* __restrict__ tw) {
#pragma unroll
  for (int hh = 8; hh >= 1; hh >>= 1)
#pragma unroll
    for (int m = 0; m < 8 / hh; ++m)
#pragma unroll
      for (int jj = 0; jj < hh; ++jj) {
        int k = m * 2 * hh + jj;
        const float wx_ = W16C[jj * (8 / hh)], wy_ = -W16S[jj * (8 / hh)];
        float dx = xr[k] - xr[k + hh], dy = xi[k] - xi[k + hh];
        xr[k] += xr[k + hh]; xi[k] += xi[k + hh];
        xr[k + hh] = dx * wx_ - dy * wy_; xi[k + hh] = dx * wy_ + dy * wx_;
      }
}
DEVI void fft16_dit_inv(float (&xr)[16], float (&xi)[16], const float2* __restrict__ tw) {
#pragma unroll
  for (int hh = 1; hh <= 8; hh <<= 1)
#pragma unroll
    for (int m = 0; m < 8 / hh; ++m)
#pragma unroll
      for (int jj = 0; jj < hh; ++jj) {
        int k = m * 2 * hh + jj;
        const float wx_ = W16C[jj * (8 / hh)], wy_ = -W16S[jj * (8 / hh)];
        float px = xr[k + hh] * wx_ + xi[k + hh] * wy_, py = xi[k + hh] * wx_ - xr[k + hh] * wy_;
        float ar = xr[k], ai = xi[k];
        xr[k] = ar + px; xi[k] = ai + py;
        xr[k + hh] = ar - px; xi[k + hh] = ai - py;
      }
}

DEVI void filter_tile(const Params& p, int j, int c, char* lds) {
  float2* z = (float2*)lds;
  float* w3s = (float*)(lds + 69632);
  float* red = w3s + 128;
  const float2* tw = (const float2*)(p.ws + OFF_TW);
  const float* H2 = (const float*)(p.ws + OFF_H2) + (size_t)j * 4096 * 64;
  __half2* HS = (__half2*)(p.ws + OFF_HSPEC);
  int t = tid();
  if (t < 128) w3s[t] = p.hy_fw3[((size_t)j * 64 + (t & 63)) * 2048 + (t >> 6) * 1024 + c];
  __syncthreads();
  const float lo = -3.0701134573253944f, hi = -15.350567286626972f;
  float delta = -(lo + (float)c * ((hi - lo) / 1023.f));
  float asum = 0.f;
#pragma unroll 1
  for (int qq = 0; qq < 16; ++qq) {
    int s = t + 256 * qq;
    const float4* hrow = (const float4*)(H2 + (size_t)s * 64);
    float hf = 0.f, hb = 0.f;
#pragma unroll 4
    for (int i4 = 0; i4 < 16; ++i4) {
      float4 hv = hrow[i4];
      float4 wf = *(const float4*)(w3s + i4 * 4);
      float4 wb = *(const float4*)(w3s + 64 + i4 * 4);
      hf += hv.x * wf.x + hv.y * wf.y + hv.z * wf.z + hv.w * wf.w;
      hb += hv.x * wb.x + hv.y * wb.y + hv.z * wb.z + hv.w * wb.w;
    }
    float tt = (float)s / 4095.f;
    float win = fexp(-tt * delta);
    float vf = hf * win, vb = hb * win;
    z[zi(s)] = make_float2(vf, 0.f);
    asum += fabsf(vf);
    if (s >= 1) { z[zi(8192 - s)] = make_float2(vb, 0.f); asum += fabsf(vb); }
  }
  if (t == 0) z[zi(4096)] = make_float2(0.f, 0.f);
  asum = wave_sum(asum);
  if ((t & 63) == 0) red[t >> 6] = asum;
  __syncthreads();
  float inv = 1.f / (red[0] + red[1] + red[2] + red[3]);
  { FftTw ftw; fft_load_tw(ftw, tw, t); fft_dif_all(z, tw, ftw, t); }
  float bias = p.hy_bias[j * 1024 + c];
  for (int k = t; k < 8192; k += 256) {
    float2 v = z[zi(k)];
    HS[(size_t)c * 8192 + k] = __floats2half2_rn(v.x * inv + bias, v.y * inv);
  }
  __syncthreads();
}

DEVI void layer_prep_phase(const Params& p, int layer, char* lds) {
  if (!(layer & 1)) {
    for (int tile = bid(); tile < 1024 + WT_T_EVEN; tile += gridDim.x) {
      if (tile < 1024) filter_tile(p, layer >> 1, tile, lds);
      else wt_tile(p, layer, tile - 1024, lds);
    }
  } else {
    for (int tile = bid(); tile < WT_T_ODD; tile += gridDim.x) wt_tile(p, layer, tile, lds);
  }
}

DEVI void norm_phase(const Params& p, int layer, int r) {
  int w = tid() >> 6, lane = tid() & 63;
  u16* hn = (u16*)(p.ws + OFF_HN);
  const float* modp = (const float*)(p.ws + OFF_MOD);
  const float* g = p.norm_g + layer * 1024;
  int nw = gridDim.x * 4;
  for (int tok0 = bid() * 4 + w; tok0 < RT; tok0 += 2 * nw) {
    float4 v[2][4]; float ss[2];
#pragma unroll
    for (int u = 0; u < 2; ++u) {
      int tok = min(tok0 + u * nw, RT - 1);
      int sl = tok >> 12, n = tok & 4095, sg = r * 4 + sl;
      const float* x = xsrc_ptr(p, layer, sg) + (size_t)n * D;
      ss[u] = 0.f;
#pragma unroll
      for (int i = 0; i < 4; ++i) { v[u][i] = *(const float4*)(x + i * 256 + lane * 4); ss[u] += v[u][i].x * v[u][i].x + v[u][i].y * v[u][i].y + v[u][i].z * v[u][i].z + v[u][i].w * v[u][i].w; }
    }
#pragma unroll
    for (int o = 32; o >= 1; o >>= 1) { ss[0] += __shfl_xor(ss[0], o); ss[1] += __shfl_xor(ss[1], o); }
#pragma unroll
    for (int u = 0; u < 2; ++u) {
      int tok = tok0 + u * nw;
      if (tok >= RT) break;
      int sl = tok >> 12, sg = r * 4 + sl;
      const float* md = modp + (size_t)(layer * 12 + sg) * 3072;
      float rs = __builtin_amdgcn_rsqf(ss[u] * (1.f / 1024.f) + 1e-6f);
#pragma unroll
      for (int i = 0; i < 4; ++i) {
        int c = i * 256 + lane * 4;
        float4 gg = *(const float4*)(g + c), sh = *(const float4*)(md + c), sc = *(const float4*)(md + 1024 + c);
        float o0 = v[u][i].x * rs * gg.x * (1.f + sc.x) + sh.x;
        float o1 = v[u][i].y * rs * gg.y * (1.f + sc.y) + sh.y;
        float o2 = v[u][i].z * rs * gg.z * (1.f + sc.z) + sh.z;
        float o3 = v[u][i].w * rs * gg.w * (1.f + sc.w) + sh.w;
        uint2 o; o.x = pack2(o0, o1); o.y = pack2(o2, o3);
        *(uint2*)(hn + (size_t)tok * 1024 + c) = o;
      }
    }
  }
}

DEVI void final_phase(const Params& p) {
  int w = tid() >> 6, lane = tid() & 63;
  int nw = gridDim.x * 4;
  const int NT = NSEQ * L;
  for (int tok0 = bid() * 4 + w; tok0 < NT; tok0 += 2 * nw) {
    float4 v[2][4]; float ss[2];
#pragma unroll
    for (int u = 0; u < 2; ++u) {
      int tok = min(tok0 + u * nw, NT - 1);
      const float* x = p.out + (size_t)tok * D;
      ss[u] = 0.f;
#pragma unroll
      for (int i = 0; i < 4; ++i) { v[u][i] = *(const float4*)(x + i * 256 + lane * 4); ss[u] += v[u][i].x * v[u][i].x + v[u][i].y * v[u][i].y + v[u][i].z * v[u][i].z + v[u][i].w * v[u][i].w; }
    }
#pragma unroll
    for (int o = 32; o >= 1; o >>= 1) { ss[0] += __shfl_xor(ss[0], o); ss[1] += __shfl_xor(ss[1], o); }
#pragma unroll
    for (int u = 0; u < 2; ++u) {
      int tok = tok0 + u * nw;
      if (tok >= NT) break;
      float* x = p.out + (size_t)tok * D;
      float rs = __builtin_amdgcn_rsqf(ss[u] * (1.f / 1024.f) + 1e-6f);
#pragma unroll
      for (int i = 0; i < 4; ++i) {
        int c = i * 256 + lane * 4;
        float4 gg = *(const float4*)(p.final_g + c);
        *(float4*)(x + c) = make_float4(v[u][i].x * rs * gg.x, v[u][i].y * rs * gg.y, v[u][i].z * rs * gg.z, v[u][i].w * rs * gg.w);
      }
    }
  }
}

DEVI void gemm_gload(const u16* __restrict__ xg, const u16* __restrict__ yg, int ldx, int ldy, int koff, u32x4 (&rx)[4], u32x4 (&ry)[4]) {
#pragma unroll
  for (int i = 0; i < 4; ++i) {
    rx[i] = *(const u32x4*)(xg + (size_t)(32 * i) * ldx + koff);
    ry[i] = *(const u32x4*)(yg + (size_t)(32 * i) * ldy + koff);
  }
}
DEVI void gemm_swrite(char* st, int lrow, int lch, const u32x4 (&rx)[4], const u32x4 (&ry)[4]) {
#pragma unroll
  for (int i = 0; i < 4; ++i) {
    int off = swz128(lrow + 32 * i, lch);
    *(u32x4*)(st + off) = rx[i]; *(u32x4*)(st + 16384 + off) = ry[i];
  }
}
DEVI void gemm_compute(const char* st, int wr, int wc, int lr, int q, f32x4 (&acc)[4][4]) {
#pragma unroll
  for (int ks = 0; ks < 2; ++ks) {
    bf16x8 xf[4], yf[4];
#pragma unroll
    for (int m = 0; m < 4; ++m) xf[m] = ldsfrag(st, swz128(wr * 64 + m * 16 + lr, ks * 4 + q));
#pragma unroll
    for (int n = 0; n < 4; ++n) yf[n] = ldsfrag(st + 16384, swz128(wc * 64 + n * 16 + lr, ks * 4 + q));
    __builtin_amdgcn_s_setprio(1);
#pragma unroll
    for (int m = 0; m < 4; ++m)
#pragma unroll
      for (int n = 0; n < 4; ++n) acc[m][n] = mfma16(xf[m], yf[n], acc[m][n]);
    __builtin_amdgcn_s_setprio(0);
  }
}
DEVI void gemm_glds_stage(const u16* __restrict__ X, int ldx, const u16* __restrict__ Y, int ldy, int koff, char* st, int w, int lane) {
#pragma unroll
  for (int i = 0; i < 4; ++i) {
    int row = 8 * w + 32 * i + (lane >> 3);
    int chunk = (lane & 7) ^ ((row >> 1) & 7);
    __builtin_amdgcn_global_load_lds((const unsigned*)(X + (size_t)row * ldx + chunk * 8 + koff), (unsigned*)(st + w * 1024 + i * 4096), 16, 0, 0);
    __builtin_amdgcn_global_load_lds((const unsigned*)(Y + (size_t)row * ldy + chunk * 8 + koff), (unsigned*)(st + 16384 + w * 1024 + i * 4096), 16, 0, 0);
  }
}
DEVI void gemm_core(const u16* __restrict__ X, int ldx, const u16* __restrict__ Y, int ldy, int K, f32x4 (&acc)[4][4], char* lds) {
  int t = tid(), w = t >> 6, lane = t & 63, q = lane >> 4, lr = lane & 15;
  int wr = w >> 1, wc = w & 1;
#pragma unroll
  for (int m = 0; m < 4; ++m)
#pragma unroll
    for (int n = 0; n < 4; ++n) acc[m][n] = f32x4{0.f, 0.f, 0.f, 0.f};
  int nk = K >> 6;
  gemm_glds_stage(X, ldx, Y, ldy, 0, lds, w, lane);
  asm volatile("s_waitcnt vmcnt(0)" ::: "memory");
  __syncthreads();
#pragma unroll 1
  for (int kt = 0; kt < nk; ++kt) {
    if (kt + 1 < nk) gemm_glds_stage(X, ldx, Y, ldy, (kt + 1) * 64, lds + ((kt + 1) & 1) * 32768, w, lane);
    gemm_compute(lds + (kt & 1) * 32768, wr, wc, lr, q, acc);
    asm volatile("s_waitcnt vmcnt(0)" ::: "memory");
    __syncthreads();
  }
}

DEVI void gemm_stage_bf16(const f32x4 (&acc)[4][4], char* lds, int wr, int wc, int lr, int q) {
#pragma unroll
  for (int m = 0; m < 4; ++m)
#pragma unroll
    for (int n = 0; n < 4; ++n) {
      int jrow = wc * 64 + n * 16 + lr, i0 = wr * 64 + m * 16 + 4 * q;
      uint2 o; o.x = pack2(acc[m][n][0], acc[m][n][1]); o.y = pack2(acc[m][n][2], acc[m][n][3]);
      *(uint2*)(lds + jrow * 272 + i0 * 2) = o;
    }
  __syncthreads();
}
DEVI void gemm_writeout(const char* lds, u16* dst, size_t pitch, int t) {
#pragma unroll
  for (int it = 0; it < 8; ++it) {
    int e = t + 256 * it; int row = e >> 4, c = e & 15;
    u32x4 v = *(const u32x4*)(lds + row * 272 + c * 16);
    *(u32x4*)(dst + (size_t)row * pitch + c * 8) = v;
  }
  __syncthreads();
}

DEVI void tile_decode(int t, int NT, int& mt, int& nt) {
  int grp = t / (8 * NT), rem = t % (8 * NT);
  nt = rem >> 3; mt = grp * 8 + (rem & 7);
}

DEVI void gemm_evin_phase(const Params& p, int j, char* lds) {
  const u16* A = (const u16*)(p.ws + OFF_HN);
  const u16* W = (const u16*)(p.ws + OFF_WT);
  u16* UT = (u16*)(p.ws + OFF_U);
  u16* US = (u16*)(p.ws + OFF_USSD);
  float* DT = (float*)(p.ws + OFF_DT);
  constexpr int NT = 57, MT = 128;
  int lane = tid() & 63, w = tid() >> 6, q = lane >> 4, lr = lane & 15, wr = w >> 1, wc = w & 1;
  for (int tile = vblock(); tile < MT * NT; tile += gridDim.x) {
    int mt, nt; tile_decode(tile, NT, mt, nt);
    f32x4 acc[4][4];
    const u16* Ap = A + (size_t)mt * 128 * 1024;
    const u16* Wp = W + (size_t)nt * 128 * 1024;
    bool cm = nt < 32;
    gemm_core(cm ? Ap : Wp, 1024, cm ? Wp : Ap, 1024, 1024, acc, lds);
    if (nt < 56) {
      gemm_stage_bf16(acc, lds, wr, wc, lr, q);
      u16* dst = cm ? (UT + ((size_t)(mt >> 5) * 4096 + nt * 128) * 4096 + ((mt * 128) & 4095))
                    : (US + (size_t)(mt * 128) * 3072 + (nt * 128 - 4096));
      gemm_writeout(lds, dst, cm ? 4096 : 3072, tid());
    } else {
#pragma unroll
      for (int m = 0; m < 4; ++m)
#pragma unroll
        for (int n = 0; n < 4; ++n) {
          int col = nt * 128 + wr * 64 + m * 16 + 4 * q;
          int tok = mt * 128 + wc * 64 + n * 16 + lr;
          if (col < 7200) *(float4*)(DT + (size_t)tok * 32 + (col - 7168)) = make_float4(acc[m][n][0], acc[m][n][1], acc[m][n][2], acc[m][n][3]);
        }
    }
  }
}

DEVI void gemm_odin_phase(const Params& p, int j, char* lds) {
  const u16* A = (const u16*)(p.ws + OFF_HN);
  const u16* W = (const u16*)(p.ws + OFF_WT);
  u16* U = (u16*)(p.ws + OFF_U);
  constexpr int NT = 32, MT = 128;
  int lane = tid() & 63, w = tid() >> 6, q = lane >> 4, lr = lane & 15, wr = w >> 1, wc = w & 1;
  for (int tile = vblock(); tile < MT * NT; tile += gridDim.x) {
    int mt, nt; tile_decode(tile, NT, mt, nt);
    f32x4 acc[4][4];
    gemm_core(W + (size_t)nt * 128 * 1024, 1024, A + (size_t)mt * 128 * 1024, 1024, 1024, acc, lds);
    gemm_stage_bf16(acc, lds, wr, wc, lr, q);
    gemm_writeout(lds, U + (size_t)(mt * 128) * 4096 + nt * 128, 4096, tid());
  }
}

DEVI void gemm_out_phase(const Params& p, int layer, int r, char* lds) {
  int j = layer >> 1;
  const u16* A = (const u16*)(p.ws + OFF_MIX);
  const u16* W = (const u16*)(p.ws + OFF_WT) + ((layer & 1) ? WTO_ODOUT : WTO_EVOUT);
  const float* modp = (const float*)(p.ws + OFF_MOD);
  constexpr int NT = 8, MT = 128;
  int lane = tid() & 63, w = tid() >> 6, q = lane >> 4, lr = lane & 15, wr = w >> 1, wc = w & 1;
  for (int tile = vblock(); tile < MT * NT; tile += gridDim.x) {
    int mt, nt; tile_decode(tile, NT, mt, nt);
    f32x4 acc[4][4];
    gemm_core(W + (size_t)nt * 128 * 2048, 2048, A + (size_t)mt * 128 * 2048, 2048, 2048, acc, lds);
    int sl = mt >> 5, sg = r * 4 + sl;
    const float* xs = xsrc_ptr(p, layer, sg);
    float* xo = p.out + (size_t)sg * L * D;
    const float* gate = modp + (size_t)(layer * 12 + sg) * 3072 + 2048;
#pragma unroll
    for (int m = 0; m < 4; ++m)
#pragma unroll
      for (int n = 0; n < 4; ++n) {
        int col = nt * 128 + wr * 64 + m * 16 + 4 * q;
        int tok = (mt * 128 + wc * 64 + n * 16 + lr) & 4095;
        float4 xv = *(const float4*)(xs + (size_t)tok * D + col);
        float4 gv = *(const float4*)(gate + col);
        float4 o = make_float4(xv.x + gv.x * acc[m][n][0], xv.y + gv.y * acc[m][n][1], xv.z + gv.z * acc[m][n][2], xv.w + gv.w * acc[m][n][3]);
        *(float4*)(xo + (size_t)tok * D + col) = o;
      }
  }
}

DEVI void hyena_tile(const Params& p, int j, int tile, char* lds) {
  int c = tile >> 1, pr = tile & 1;
  float2* z = (float2*)lds;
  float* zf = (float*)lds;
  const float2* tw = (const float2*)(p.ws + OFF_TW);
  const __half2* HS = (const __half2*)(p.ws + OFF_HSPEC) + (size_t)c * 8192;
  u16* UT = (u16*)(p.ws + OFF_U);
  int t = tid();
  const float* cw = p.hy_conv_w + (size_t)j * 3 * 3072;
  const float* cb = p.hy_conv_b + (size_t)j * 3072;
  int n0 = t * 16;
  FftTw ftw; fft_load_tw(ftw, tw, t);
#pragma unroll 1
  for (int s = 0; s < 2; ++s) {
    int sl = pr * 2 + s;
    float vfv[16];
#pragma unroll
    for (int k = 0; k < 16; ++k) vfv[k] = 1.f;
#pragma unroll
    for (int which = 1; which <= 2; ++which) {
      int col = which * 1024 + c;
      const u16* src = UT + ((size_t)sl * 4096 + col) * 4096;
      float raw[18];
      uint4 a = *(const uint4*)(src + n0), b = *(const uint4*)(src + n0 + 8);
      float f0[8], f1[8]; unpack8(a, f0); unpack8(b, f1);
#pragma unroll
      for (int k = 0; k < 8; ++k) { raw[1 + k] = f0[k]; raw[9 + k] = f1[k]; }
      raw[0] = (n0 > 0) ? bf2f(src[n0 - 1]) : 0.f;
      raw[17] = (n0 + 16 < 4096) ? bf2f(src[n0 + 16]) : 0.f;
      float w0 = cw[0 * 3072 + col], w1 = cw[1 * 3072 + col], w2 = cw[2 * 3072 + col], bb = cb[col];
#pragma unroll
      for (int k = 0; k < 16; ++k) vfv[k] *= (bb + w0 * raw[k] + w1 * raw[k + 1] + w2 * raw[k + 2]);
    }
#pragma unroll
    for (int k = 0; k < 16; ++k) zf[(17 * t + k) * 2 + s] = vfv[k];
  }
  for (int k = t; k < 4096; k += 256) z[zi(4096 + k)] = make_float2(0.f, 0.f);
  __syncthreads();
  fft_dif_all(z, tw, ftw, t);
  for (int k = t; k < 8192; k += 256) {
    float2 v = z[zi(k)], h = __half22float2(HS[k]);
    z[zi(k)] = make_float2(v.x * h.x - v.y * h.y, v.x * h.y + v.y * h.x);
  }
  __syncthreads();
  fft_dit_all(z, tw, ftw, t);
#pragma unroll 1
  for (int s = 0; s < 2; ++s) {
    int sl = pr * 2 + s;
    const u16* src = UT + ((size_t)sl * 4096 + c) * 4096;
    const u16* gsrc = UT + ((size_t)sl * 4096 + 3072 + c) * 4096;
    u16* dst = UT + ((size_t)sl * 4096 + 2048 + c) * 4096;
    float raw[18];
    uint4 a = *(const uint4*)(src + n0), b = *(const uint4*)(src + n0 + 8);
    float f0[8], f1[8]; unpack8(a, f0); unpack8(b, f1);
#pragma unroll
    for (int k = 0; k < 8; ++k) { raw[1 + k] = f0[k]; raw[9 + k] = f1[k]; }
    raw[0] = (n0 > 0) ? bf2f(src[n0 - 1]) : 0.f;
    raw[17] = (n0 + 16 < 4096) ? bf2f(src[n0 + 16]) : 0.f;
    float w0 = cw[0 * 3072 + c], w1 = cw[1 * 3072 + c], w2 = cw[2 * 3072 + c], bb = cb[c];
    uint4 ga = *(const uint4*)(gsrc + n0), gb = *(const uint4*)(gsrc + n0 + 8);
    float g0[8], g1[8]; unpack8(ga, g0); unpack8(gb, g1);
    float o0[8], o1[8];
#pragma unroll
    for (int k = 0; k < 8; ++k) {
      float x0 = bb + w0 * raw[k] + w1 * raw[k + 1] + w2 * raw[k + 2];
      float y = zf[(17 * t + k) * 2 + s] * (1.f / 8192.f);
      o0[k] = x0 * y * silu_f(g0[k]);
      float x0b = bb + w0 * raw[k + 8] + w1 * raw[k + 9] + w2 * raw[k + 10];
      float yb = zf[(17 * t + k + 8) * 2 + s] * (1.f / 8192.f);
      o1[k] = x0b * yb * silu_f(g1[k]);
    }
    *(uint4*)(dst + n0) = pack8(o0);
    *(uint4*)(dst + n0 + 8) = pack8(o1);
  }
  __syncthreads();
}

template <int NR, bool SILU>
DEVI void conv4_run(const u16* __restrict__ U, int ld, int col, int nb, const float* __restrict__ cw, const float* __restrict__ cb, int cidx, int cwld,
                    float (&out)[NR][8]) {
  float bias[8];
  {
    float4 b0 = *(const float4*)(cb + cidx), b1 = *(const float4*)(cb + cidx + 4);
    bias[0] = b0.x; bias[1] = b0.y; bias[2] = b0.z; bias[3] = b0.w; bias[4] = b1.x; bias[5] = b1.y; bias[6] = b1.z; bias[7] = b1.w;
  }
#pragma unroll
  for (int i = 0; i < NR; ++i)
#pragma unroll
    for (int e = 0; e < 8; ++e) out[i][e] = bias[e];
#pragma unroll
  for (int rr = 0; rr < NR + 3; ++rr) {
    int n = nb - 2 + rr;
    float f[8];
    if (n >= 0 && n < 4096) { uint4 v = *(const uint4*)(U + (size_t)n * ld + col); unpack8(v, f); }
    else {
#pragma unroll
      for (int e = 0; e < 8; ++e) f[e] = 0.f;
    }
#pragma unroll
    for (int k = 0; k < 4; ++k) {
      int i = rr - k;
      if (i >= 0 && i < NR) {
        float4 w0 = *(const float4*)(cw + (size_t)k * cwld + cidx), w1 = *(const float4*)(cw + (size_t)k * cwld + cidx + 4);
        out[i][0] += w0.x * f[0]; out[i][1] += w0.y * f[1]; out[i][2] += w0.z * f[2]; out[i][3] += w0.w * f[3];
        out[i][4] += w1.x * f[4]; out[i][5] += w1.y * f[5]; out[i][6] += w1.z * f[6]; out[i][7] += w1.w * f[7];
      }
    }
  }
  if (SILU) {
#pragma unroll
    for (int i = 0; i < NR; ++i)
#pragma unroll
      for (int e = 0; e < 8; ++e) out[i][e] = silu_f(out[i][e]);
  }
}

DEVI void act_phase(const Params& p, int layer) {
  int j = layer >> 1; bool odd = layer & 1;
  u16* XA = (u16*)(p.ws + OFF_XACT);
  const u16* Ub = (const u16*)(p.ws + (odd ? OFF_U : OFF_USSD));
  int ld = odd ? 4096 : 3072, cbase = odd ? 0 : 1024;
  const float* cw = (odd ? p.lru_conv_w : p.ssd_conv_w) + (size_t)j * 4 * 2048;
  const float* cb = (odd ? p.lru_conv_b : p.ssd_conv_b) + (size_t)j * 2048;
  int total = 256 * (RT / 8);
  for (int e = bid() * 256 + tid(); e < total; e += gridDim.x * 256) {
    int ch8 = e & 255, run = e >> 8;
    int tok0 = run * 8, sl = tok0 >> 12, nb = tok0 & 4095;
    float o[8][8];
    if (odd) conv4_run<8, false>(Ub + (size_t)sl * 4096 * ld, ld, cbase + ch8 * 8, nb, cw, cb, ch8 * 8, 2048, o);
    else conv4_run<8, true>(Ub + (size_t)sl * 4096 * ld, ld, cbase + ch8 * 8, nb, cw, cb, ch8 * 8, 2048, o);
#pragma unroll
    for (int i = 0; i < 8; ++i) *(uint4*)(XA + (size_t)(tok0 + i) * 2048 + ch8 * 8) = pack8(o[i]);
  }
}

DEVI void ssd_gload(const u16* __restrict__ XA, const float* __restrict__ DTR, int n0, int g, int hd, int dir, int t, u32x4 (&rc)[4], u32x4 (&rb)[4], u32x4 (&rxs)[2], float& dtraw) {
#pragma unroll
  for (int i = 0; i < 4; ++i) {
    int row = 2 * (t & 15) + (i & 1) + 32 * (i >> 1), ch8 = t >> 4;
    const u16* src = XA + (size_t)(n0 + row) * 2048 + g * 128 + ch8 * 8;
    rc[i] = *(const u32x4*)(src + 1536);
    rb[i] = *(const u32x4*)(src + 1024);
  }
#pragma unroll
  for (int i = 0; i < 2; ++i) {
    int row = 2 * (t & 15) + i + 32 * (t >> 7), c8 = (t >> 4) & 7;
    rxs[i] = *(const u32x4*)(XA + (size_t)(n0 + row) * 2048 + hd * 64 + c8 * 8);
  }
  int lane = t & 63;
  int n = dir ? (n0 + 63 - lane) : (n0 + lane);
  dtraw = DTR[(size_t)n * 32 + dir * 16 + hd];
}

DEVI void ssd_tile(const Params& p, int j, int tile, char* lds) {
  int sl = tile >> 5, hd = (tile >> 1) & 15, dir = tile & 1;
  int g = hd >> 2;
  const u16* XA = (const u16*)(p.ws + OFF_XACT) + (size_t)sl * 4096 * 2048;
  const float* DTR = (const float*)(p.ws + OFF_DT) + (size_t)sl * 4096 * 32;
  u16* Yo = (u16*)(p.ws + (dir ? OFF_YB : OFF_YF)) + (size_t)sl * 4096 * 1024;
  char* Cs = lds; char* Bs = lds + 16384; char* BTs = lds + 32768; char* XTs = lds + 49152; char* Sb = lds + 57344;
  float* sm = (float*)(lds + 73728);
  int t = tid(), w = t >> 6, lane = t & 63, q = lane >> 4, lr = lane & 15, wi = w >> 1, wj = w & 1;
  float dtb = p.ssd_dt_bias[(j * 2 + dir) * 16 + hd];
  float aneg = -fexp(p.ssd_A_log[(j * 2 + dir) * 16 + hd]);
  f32x4 Sacc[4][2];
#pragma unroll
  for (int a = 0; a < 4; ++a)
#pragma unroll
    for (int b = 0; b < 2; ++b) Sacc[a][b] = f32x4{0.f, 0.f, 0.f, 0.f};
  for (int e = t; e < 1024; e += 256) *(uint4*)(Sb + e * 16) = make_uint4(0, 0, 0, 0);
  u32x4 rc[4], rb[4], rxs[2]; float dtraw;
  ssd_gload(XA, DTR, dir ? (4096 - 64) : 0, g, hd, dir, t, rc, rb, rxs, dtraw);

#pragma unroll 1
  for (int cc = 0; cc < 64; ++cc) {
    int par = cc & 1;
    float* dts = sm + par * 64; float* acum = sm + 128 + par * 64;
    int n0 = dir ? (4096 - 64 * (cc + 1)) : 64 * cc;
    if (w == 0) {
      float dtv = softplus_f(dtraw + dtb);
      float x = dtv * aneg;
#pragma unroll
      for (int o = 1; o < 64; o <<= 1) { float v = __shfl_up(x, o); if (lane >= o) x += v; }
      dts[lane] = dtv; acum[lane] = x;
    }
    lds_barrier();
    float alast = acum[63];
    {
      int ch8 = t >> 4, rl = t & 15;
#pragma unroll
      for (int pr = 0; pr < 2; ++pr) {
        int row0 = 2 * rl + 32 * pr;
        int le = dir ? (62 - row0) : row0;
        u32x4 ce = dir ? rc[2 * pr + 1] : rc[2 * pr], co = dir ? rc[2 * pr] : rc[2 * pr + 1];
        u32x4 be = dir ? rb[2 * pr + 1] : rb[2 * pr], bo = dir ? rb[2 * pr] : rb[2 * pr + 1];
        *(u32x4*)(Cs + swz256(le, ch8)) = ce; *(u32x4*)(Cs + swz256(le + 1, ch8)) = co;
        *(u32x4*)(Bs + swz256(le, ch8)) = be; *(u32x4*)(Bs + swz256(le + 1, ch8)) = bo;
        float fe[8], fo[8]; unpack8v(be, fe); unpack8v(bo, fo);
        float de = fexp(alast - acum[le]), dod = fexp(alast - acum[le + 1]);
        char* bt = BTs + (le & 7) * 2;
#pragma unroll
        for (int e2 = 0; e2 < 8; ++e2) {
          int nn = ch8 * 8 + e2;
          *(unsigned*)(bt + swz128(nn, le >> 3)) = pack2(fe[e2] * de, fo[e2] * dod);
        }
      }
    }
    {
      int c8 = (t >> 4) & 7, rl = t & 15;
      int row0 = 2 * rl + 32 * (t >> 7);
      int le = dir ? (62 - row0) : row0;
      u32x4 xe = dir ? rxs[1] : rxs[0], xo = dir ? rxs[0] : rxs[1];
      float fe[8], fo[8]; unpack8v(xe, fe); unpack8v(xo, fo);
      float de = dts[le], dod = dts[le + 1];
      char* xt = XTs + (le & 7) * 2;
#pragma unroll
      for (int e2 = 0; e2 < 8; ++e2) {
        int pp = c8 * 8 + e2;
        *(unsigned*)(xt + swz128(pp, le >> 3)) = pack2(fe[e2] * de, fo[e2] * dod);
      }
    }
    { int cn = min(cc + 1, 63); ssd_gload(XA, DTR, dir ? (4096 - 64 * (cn + 1)) : 64 * cn, g, hd, dir, t, rc, rb, rxs, dtraw); }
    __builtin_amdgcn_sched_barrier(0);
    lds_barrier();
    f32x4 aoff[2][2], cbm[2][2];
#pragma unroll
    for (int m = 0; m < 2; ++m)
#pragma unroll
      for (int n = 0; n < 2; ++n) { aoff[m][n] = f32x4{0.f, 0.f, 0.f, 0.f}; cbm[m][n] = f32x4{0.f, 0.f, 0.f, 0.f}; }
#pragma unroll
    for (int ks = 0; ks < 4; ++ks) {
      bf16x8 sf[2], bf[2], cf[2];
#pragma unroll
      for (int m = 0; m < 2; ++m) {
        int row = (2 * wi + m) * 16 + lr;
        sf[m] = ldsfrag(Sb, swz256(row, ks * 4 + q));
        bf[m] = ldsfrag(Bs, swz256(row, ks * 4 + q));
      }
#pragma unroll
      for (int n = 0; n < 2; ++n) cf[n] = ldsfrag(Cs, swz256((2 * wj + n) * 16 + lr, ks * 4 + q));
      __builtin_amdgcn_s_setprio(1);
#pragma unroll
      for (int m = 0; m < 2; ++m)
#pragma unroll
        for (int n = 0; n < 2; ++n) { aoff[m][n] = mfma16(sf[m], cf[n], aoff[m][n]); cbm[m][n] = mfma16(bf[m], cf[n], cbm[m][n]); }
      __builtin_amdgcn_s_setprio(0);
    }
    lds_barrier();
    char* Ms = Bs;
#pragma unroll
    for (int m = 0; m < 2; ++m)
#pragma unroll
      for (int n = 0; n < 2; ++n) {
        int l = (2 * wj + n) * 16 + lr; int s0 = (2 * wi + m) * 16 + 4 * q;
        float al = acum[l];
        float v[4];
#pragma unroll
        for (int rg = 0; rg < 4; ++rg) { int s = s0 + rg; v[rg] = (l >= s) ? cbm[m][n][rg] * fexp(al - acum[s]) : 0.f; }
        uint2 o; o.x = pack2(v[0], v[1]); o.y = pack2(v[2], v[3]);
        *(uint2*)(Ms + swz128(l, s0 >> 3) + (s0 & 7) * 2) = o;
      }
    lds_barrier();
    f32x4 adg[2][2];
#pragma unroll
    for (int m = 0; m < 2; ++m)
#pragma unroll
      for (int n = 0; n < 2; ++n) adg[m][n] = f32x4{0.f, 0.f, 0.f, 0.f};
    float cdec = fexp(alast);
#pragma unroll
    for (int a = 0; a < 4; ++a)
#pragma unroll
      for (int b = 0; b < 2; ++b) { Sacc[a][b][0] *= cdec; Sacc[a][b][1] *= cdec; Sacc[a][b][2] *= cdec; Sacc[a][b][3] *= cdec; }
#pragma unroll
    for (int ks = 0; ks < 2; ++ks) {
      bf16x8 xf[2], mf[2], btf[4], xyf[2];
#pragma unroll
      for (int m = 0; m < 2; ++m) xf[m] = ldsfrag(XTs, swz128((2 * wi + m) * 16 + lr, ks * 4 + q));
#pragma unroll
      for (int n = 0; n < 2; ++n) mf[n] = ldsfrag(Ms, swz128((2 * wj + n) * 16 + lr, ks * 4 + q));
      __builtin_amdgcn_s_setprio(1);
#pragma unroll
      for (int m = 0; m < 2; ++m)
#pragma unroll
        for (int n = 0; n < 2; ++n) adg[m][n] = mfma16(xf[m], mf[n], adg[m][n]);
      __builtin_amdgcn_s_setprio(0);
#pragma unroll
      for (int a = 0; a < 4; ++a) btf[a] = ldsfrag(BTs, swz128((4 * wi + a) * 16 + lr, ks * 4 + q));
#pragma unroll
      for (int b = 0; b < 2; ++b) xyf[b] = ldsfrag(XTs, swz128((2 * wj + b) * 16 + lr, ks * 4 + q));
      __builtin_amdgcn_s_setprio(1);
#pragma unroll
      for (int a = 0; a < 4; ++a)
#pragma unroll
        for (int b = 0; b < 2; ++b) Sacc[a][b] = mfma16(btf[a], xyf[b], Sacc[a][b]);
      __builtin_amdgcn_s_setprio(0);
    }
#pragma unroll
    for (int m = 0; m < 2; ++m)
#pragma unroll
      for (int n = 0; n < 2; ++n) {
        int l = (2 * wj + n) * 16 + lr; int p0 = (2 * wi + m) * 16 + 4 * q;
        float e = fexp(acum[l]);
        int ntok = dir ? (n0 + 63 - l) : (n0 + l);
        uint2 o; o.x = pack2(adg[m][n][0] + e * aoff[m][n][0], adg[m][n][1] + e * aoff[m][n][1]);
        o.y = pack2(adg[m][n][2] + e * aoff[m][n][2], adg[m][n][3] + e * aoff[m][n][3]);
        *(uint2*)(Yo + (size_t)ntok * 1024 + hd * 64 + p0) = o;
      }
#pragma unroll
    for (int a = 0; a < 4; ++a)
#pragma unroll
      for (int b = 0; b < 2; ++b) {
        int pc = (2 * wj + b) * 16 + lr; int nn0 = (4 * wi + a) * 16 + 4 * q;
        uint2 o; o.x = pack2(Sacc[a][b][0], Sacc[a][b][1]); o.y = pack2(Sacc[a][b][2], Sacc[a][b][3]);
        *(uint2*)(Sb + swz256(pc, nn0 >> 3) + (nn0 & 7) * 2) = o;
      }
  }
  __syncthreads();
}

DEVI void even_mixer_phase(const Params& p, int j, char* lds) {
  int nb = gridDim.x, b = bid();
  if (nb == 512) {
    if (b < 128) ssd_tile(p, j, b, lds);
    else { for (int k = b - 128; k < 2048; k += 384) hyena_tile(p, j, k, lds); }
  } else {
    for (int tile = b; tile < 128 + 2048; tile += nb) {
      if (tile < 128) ssd_tile(p, j, tile, lds);
      else hyena_tile(p, j, tile - 128, lds);
    }
  }
}

DEVI void even_final_phase(const Params& p, int j, char* lds) {
  int t = tid(), w = t >> 6, lane = t & 63;
  const u16* US = (const u16*)(p.ws + OFF_USSD);
  const u16* YF = (const u16*)(p.ws + OFF_YF);
  const u16* YB = (const u16*)(p.ws + OFF_YB);
  const u16* UT = (const u16*)(p.ws + OFF_U);
  const u16* XA = (const u16*)(p.ws + OFF_XACT);
  u16* MIX = (u16*)(p.ws + OFF_MIX);
  constexpr int T_SSD = RT / 16;
  constexpr int T_HY = RS * 64 * 16;
  for (int tile = bid(); tile < T_SSD + T_HY; tile += gridDim.x) {
    if (tile < T_SSD) {
#pragma unroll 1
      for (int tk = w; tk < 16; tk += 4) {
        int tok = tile * 16 + tk;
        uint2 xr[4], yf[4], yb[4], zz[4];
#pragma unroll
        for (int g = 0; g < 4; ++g) {
          int ch = g * 256 + lane * 4;
          xr[g] = *(const uint2*)(XA + (size_t)tok * 2048 + ch);
          yf[g] = *(const uint2*)(YF + (size_t)tok * 1024 + ch);
          yb[g] = *(const uint2*)(YB + (size_t)tok * 1024 + ch);
          zz[g] = *(const uint2*)(US + (size_t)tok * 3072 + ch);
        }
        float y[4][4], ss[4];
#pragma unroll
        for (int g = 0; g < 4; ++g) {
          int ch = g * 256 + lane * 4;
          float dsk = p.ssd_D[j * 16 + (ch >> 6)];
          y[g][0] = (bflo(yf[g].x) + bflo(yb[g].x) + bflo(xr[g].x) * dsk) * silu_f(bflo(zz[g].x));
          y[g][1] = (bfhi(yf[g].x) + bfhi(yb[g].x) + bfhi(xr[g].x) * dsk) * silu_f(bfhi(zz[g].x));
          y[g][2] = (bflo(yf[g].y) + bflo(yb[g].y) + bflo(xr[g].y) * dsk) * silu_f(bflo(zz[g].y));
          y[g][3] = (bfhi(yf[g].y) + bfhi(yb[g].y) + bfhi(xr[g].y) * dsk) * silu_f(bfhi(zz[g].y));
          ss[g] = y[g][0] * y[g][0] + y[g][1] * y[g][1] + y[g][2] * y[g][2] + y[g][3] * y[g][3];
        }
#pragma unroll
        for (int o = 32; o >= 1; o >>= 1) {
#pragma unroll
          for (int g = 0; g < 4; ++g) ss[g] += __shfl_xor(ss[g], o);
        }
#pragma unroll
        for (int g = 0; g < 4; ++g) {
          int ch = g * 256 + lane * 4;
          float rs = __builtin_amdgcn_rsqf(ss[g] * (1.f / 256.f) + 1e-5f);
          float4 ng = *(const float4*)(p.ssd_norm_g + j * 1024 + ch);
          uint2 o; o.x = pack2(y[g][0] * rs * ng.x, y[g][1] * rs * ng.y); o.y = pack2(y[g][2] * rs * ng.z, y[g][3] * rs * ng.w);
          *(uint2*)(MIX + (size_t)tok * 2048 + 1024 + ch) = o;
        }
      }
    } else {
      int tt = tile - T_SSD;
      int sl = tt >> 10, tb = (tt >> 4) & 63, cbk = tt & 15;
      u16* ts = (u16*)lds;
#pragma unroll
      for (int i = 0; i < 2; ++i) {
        int e = t + 256 * i; int c = e >> 3, n8 = e & 7;
        uint4 v = *(const uint4*)(UT + ((size_t)sl * 4096 + 2048 + cbk * 64 + c) * 4096 + tb * 64 + n8 * 8);
        *(uint4*)(ts + c * 72 + n8 * 8) = v;
      }
      __syncthreads();
#pragma unroll
      for (int i = 0; i < 2; ++i) {
        int e = t + 256 * i; int n = e >> 3, c8 = e & 7;
        unsigned wv[4];
#pragma unroll
        for (int k = 0; k < 4; ++k) wv[k] = (unsigned)ts[(c8 * 8 + 2 * k) * 72 + n] | ((unsigned)ts[(c8 * 8 + 2 * k + 1) * 72 + n] << 16);
        *(uint4*)(MIX + ((size_t)sl * 4096 + tb * 64 + n) * 2048 + cbk * 64 + c8 * 8) = make_uint4(wv[0], wv[1], wv[2], wv[3]);
      }
      __syncthreads();
    }
  }
}

DEVI void lru_tile(const Params& p, int j, int tile, char* lds) {
  constexpr int CT = 64;
  constexpr int NCH = 4096 / CT;
  int sl = tile >> 6, h = (tile >> 2) & 15, dir = (tile >> 1) & 1, hf2 = tile & 1;
  const u16* XA = (const u16*)(p.ws + OFF_XACT) + (size_t)sl * 4096 * 2048;
  u16* Ho = (u16*)(p.ws + (dir ? OFF_HB : OFF_HF)) + (size_t)sl * 4096 * 2048;
  int t = tid(), w = t >> 6, lane = t & 63, q = lane >> 4, lr = lane & 15;
  char* Xs0 = lds;
  float* As = (float*)(lds + 32768 + w * 10240);
  float* Us = As + CT * 20;
  const u16* Wa = (const u16*)(p.ws + OFF_WT) + WTO_LRU + ((size_t)((dir * 2 + 0) * 16 + h)) * 16384;
  const u16* Wx = (const u16*)(p.ws + OFF_WT) + WTO_LRU + ((size_t)((dir * 2 + 1) * 16 + h)) * 16384;
  bf16x8 wa[4], wx[4];
#pragma unroll
  for (int ks = 0; ks < 4; ++ks) {
    int row = 64 * hf2 + w * 16 + lr;
    wa[ks] = *(const bf16x8*)(Wa + row * 128 + ks * 32 + q * 8);
    wx[ks] = *(const bf16x8*)(Wx + row * 128 + ks * 32 + q * 8);
  }
  float ba[4], bx[4], ls[4];
#pragma unroll
  for (int rg = 0; rg < 4; ++rg) {
    int n = 64 * hf2 + w * 16 + 4 * q + rg;
    int cidx = (j * 2 + dir) * 2048 + h * 128 + n;
    ba[rg] = -1.4426950408889634f * p.lru_b_a[cidx]; bx[rg] = -1.4426950408889634f * p.lru_b_x[cidx];
    ls[rg] = -8.f * 1.4426950408889634f * softplus_f(-p.lru_lam[cidx]);
  }
  float hstate = 0.f;
  u32x4 r0[4], r1[4];
#define LRU_LOAD(R, TILE) do { int _cn = min((TILE), NCH - 1); int _n1 = dir ? (4096 - CT * (_cn + 1)) : CT * _cn; \
    _Pragma("unroll") for (int i = 0; i < 4; ++i) { int e = t + 256 * i; R[i] = *(const u32x4*)(XA + (size_t)(_n1 + (e >> 4)) * 2048 + h * 128 + (e & 15) * 8); } } while (0)
  {
    int n0 = dir ? (4096 - CT) : 0;
#pragma unroll
    for (int i = 0; i < 4; ++i) {
      int e = t + 256 * i; int row = e >> 4, ch8 = e & 15;
      u32x4 v = *(const u32x4*)(XA + (size_t)(n0 + row) * 2048 + h * 128 + ch8 * 8);
      int l = dir ? (CT - 1 - row) : row;
      *(u32x4*)(Xs0 + swz256(l, ch8)) = v;
    }
    LRU_LOAD(r1, 1); LRU_LOAD(r0, 2);
  }
  lds_barrier();
#define LRU_CHUNK(CC, R) do {                                                                              \
    const int cc = (CC);                                                                                   \
    char* Xs = Xs0 + (cc & 1) * 16384;                                                                     \
    char* Xn = Xs0 + ((cc + 1) & 1) * 16384;                                                               \
    _Pragma("unroll") for (int i = 0; i < 4; ++i) {                                                        \
      int e = t + 256 * i; int row = e >> 4, ch8 = e & 15;                                                 \
      int l = dir ? (CT - 1 - row) : row;                                                                  \
      *(u32x4*)(Xn + swz256(l, ch8)) = R[i];                                                               \
    }                                                                                                      \
    LRU_LOAD(R, cc + 3);                                                                                   \
    __builtin_amdgcn_sched_barrier(0);                                                                     \
    _Pragma("unroll") for (int jh = 0; jh < 2; ++jh) {                                                     \
      f32x4 aa[2], ax[2];                                                                                  \
      _Pragma("unroll") for (int jt = 0; jt < 2; ++jt) { aa[jt] = f32x4{0.f, 0.f, 0.f, 0.f}; ax[jt] = f32x4{0.f, 0.f, 0.f, 0.f}; } \
      _Pragma("unroll") for (int ks = 0; ks < 4; ++ks) {                                                   \
        _Pragma("unroll") for (int jt = 0; jt < 2; ++jt) {                                                 \
          bf16x8 yf = ldsfrag(Xs, swz256((jh * 2 + jt) * 16 + lr, ks * 4 + q));                            \
          aa[jt] = mfma16(wa[ks], yf, aa[jt]); ax[jt] = mfma16(wx[ks], yf, ax[jt]);                        \
        }                                                                                                  \
      }                                                                                                    \
      _Pragma("unroll") for (int jt = 0; jt < 2; ++jt) {                                                   \
        int tok = (jh * 2 + jt) * 16 + lr; int nc = 64 * hf2 + w * 16 + 4 * q;                             \
        uint2 xr = *(const uint2*)(Xs + swz256(tok, nc >> 3) + (nc & 7) * 2);                              \
        float xv[4] = {bflo(xr.x), bfhi(xr.x), bflo(xr.y), bfhi(xr.y)};                                    \
        float av[4], uv[4];                                                                                \
        _Pragma("unroll") for (int rg = 0; rg < 4; ++rg) {                                                 \
          float r = rcp_f(1.f + __builtin_amdgcn_exp2f(fmaf(aa[jt][rg], -1.4426950408889634f, ba[rg])));   \
          float ig = rcp_f(1.f + __builtin_amdgcn_exp2f(fmaf(ax[jt][rg], -1.4426950408889634f, bx[rg])));  \
          float a = __builtin_amdgcn_exp2f(r * ls[rg]);                                                    \
          av[rg] = a;                                                                                      \
          uv[rg] = xv[rg] * ig * __builtin_amdgcn_sqrtf(fmaxf(fmaf(-a, a, 1.f), 0.f));                                      \
        }                                                                                                  \
        *(float4*)(As + tok * 20 + 4 * q) = make_float4(av[0], av[1], av[2], av[3]);                       \
        *(float4*)(Us + tok * 20 + 4 * q) = make_float4(uv[0], uv[1], uv[2], uv[3]);                       \
      }                                                                                                    \
    }                                                                                                      \
    asm volatile("s_waitcnt lgkmcnt(0)" ::: "memory");                                                     \
    {     \
      float hl_[16], pl_[16];                                                                              \
      {                                                                                                    \
        float av_[16], uv_[16];                                                                            \
        _Pragma("unroll") for (int k = 0; k < 16; ++k) { av_[k] = As[(16 * q + k) * 20 + lr]; uv_[k] = Us[(16 * q + k) * 20 + lr]; } \
        float hh = 0.f, pp = 1.f;                                                                          \
        _Pragma("unroll") for (int k = 0; k < 16; ++k) { hh = av_[k] * hh + uv_[k]; pp *= av_[k]; hl_[k] = hh; pl_[k] = pp; } \
      }                                                                                                    \
      float pe0 = __shfl(pl_[15], lr), he0 = __shfl(hl_[15], lr);                                          \
      float pe1 = __shfl(pl_[15], lr + 16), he1 = __shfl(hl_[15], lr + 16);                                \
      float pe2 = __shfl(pl_[15], lr + 32), he2 = __shfl(hl_[15], lr + 32);                                \
      float pe3 = __shfl(pl_[15], lr + 48), he3 = __shfl(hl_[15], lr + 48);                                \
      float c1 = pe0 * hstate + he0, c2 = pe1 * c1 + he1, c3 = pe2 * c2 + he2;                             \
      float cin = (q == 0) ? hstate : (q == 1) ? c1 : (q == 2) ? c2 : c3;                                  \
      hstate = pe3 * c3 + he3;                                                                             \
      _Pragma("unroll") for (int k = 0; k < 16; ++k) As[(16 * q + k) * 20 + lr] = hl_[k] + pl_[k] * cin;     \
    }                                                                                                      \
    asm volatile("s_waitcnt lgkmcnt(0)" ::: "memory");                                                     \
    {                                                        \
      float4 h0 = *(const float4*)(As + lane * 20), h1 = *(const float4*)(As + lane * 20 + 4);             \
      float4 h2 = *(const float4*)(As + lane * 20 + 8), h3 = *(const float4*)(As + lane * 20 + 12);        \
      int n0c = dir ? (4096 - CT * (cc + 1)) : CT * cc;                                                    \
      int ntok = dir ? (n0c + CT - 1 - lane) : (n0c + lane);                                               \
      u32x4 o0, o1;                                                                                        \
      o0[0] = pack2(h0.x, h0.y); o0[1] = pack2(h0.z, h0.w); o0[2] = pack2(h1.x, h1.y); o0[3] = pack2(h1.z, h1.w); \
      o1[0] = pack2(h2.x, h2.y); o1[1] = pack2(h2.z, h2.w); o1[2] = pack2(h3.x, h3.y); o1[3] = pack2(h3.z, h3.w); \
      u16* dst = Ho + (size_t)ntok * 2048 + h * 128 + 64 * hf2 + 16 * w;                                   \
      *(u32x4*)dst = o0; *(u32x4*)(dst + 8) = o1;                                                          \
    }                                                                                                      \
    lds_barrier();                                                                                         \
  } while (0)
#pragma unroll 1
  for (int c2 = 0; c2 < NCH; c2 += 2) {
    LRU_CHUNK(c2 + 0, r1);
    LRU_CHUNK(c2 + 1, r0);
  }
#undef LRU_CHUNK
#undef LRU_LOAD
  __syncthreads();
}

DEVI void lru_phase(const Params& p, int j, char* lds) {
  for (int tile = bid(); tile < 256; tile += gridDim.x) lru_tile(p, j, tile, lds);
}

DEVI void odd_final_phase(const Params& p) {
  const u16* HF = (const u16*)(p.ws + OFF_HF);
  const u16* HB = (const u16*)(p.ws + OFF_HB);
  const u16* U = (const u16*)(p.ws + OFF_U);
  u16* MIX = (u16*)(p.ws + OFF_MIX);
  size_t total = (size_t)RT * 256;
  for (size_t e = (size_t)bid() * 256 + tid(); e < total; e += (size_t)gridDim.x * 256) {
    size_t tok = e >> 8; int c = (int)(e & 255) * 8;
    uint4 a = *(const uint4*)(HF + tok * 2048 + c), b = *(const uint4*)(HB + tok * 2048 + c), gt = *(const uint4*)(U + tok * 4096 + 2048 + c);
    float fa[8], fb[8], fg[8], o[8];
    unpack8(a, fa); unpack8(b, fb); unpack8(gt, fg);
#pragma unroll
    for (int k = 0; k < 8; ++k) o[k] = (fa[k] + fb[k]) * silu_f(fg[k]);
    *(uint4*)(MIX + tok * 2048 + c) = pack8(o);
  }
}

constexpr int NPHASE = 82;
DEVI bool phase_exists(int ph) {
  if (ph == 0 || ph == 81) return true;
  int s = (ph - 1) % 20;
  if (s > 18) return false;
  if (s >= 1 && (s - 1) % 6 == 0) return false;
  return true;
}
DEVI void run_phase(const Params& p, int ph, char* lds) {
  if (ph == 0) { prep_phase(p, lds); return; }
  if (ph == 81) { final_phase(p); return; }
  int q = ph - 1, layer = q / 20, s = q % 20, j = layer >> 1;
  bool odd = layer & 1;
  if (s == 0) { layer_prep_phase(p, layer, lds); norm_phase(p, layer, 0); return; }
  int r = (s - 1) / 6, step = (s - 1) % 6;
  switch (step) {
    case 0: norm_phase(p, layer, r); break;
    case 1: if (odd) gemm_odin_phase(p, j, lds); else gemm_evin_phase(p, j, lds); break;
    case 2: act_phase(p, layer); break;
    case 3: if (odd) lru_phase(p, j, lds); else even_mixer_phase(p, j, lds); break;
    case 4: if (odd) odd_final_phase(p); else even_final_phase(p, j, lds); break;
    case 5: gemm_out_phase(p, layer, r, lds); if (r < NROUND - 1) norm_phase(p, layer, r + 1); break;
  }
}

__global__ void __launch_bounds__(NTHR, 2) fwd_kernel(Params p, int ph0, int ph1) {
  __shared__ __attribute__((aligned(16))) char lds[SMEM_BYTES];
  __shared__ uint4 xb_words;
  cg::grid_group grid = cg::this_grid();
  if (threadIdx.x == 0) xb_words = make_uint4(0u, 0u, 0u, 0u);
  __syncthreads();
  XcdBarrier xb = xcd_barrier_post((unsigned*)(p.ws + OFF_BAR), (volatile LAS unsigned*)&xb_words);
  for (int ph = ph0; ph < ph1; ++ph) {
    if (!phase_exists(ph)) continue;
    run_phase(p, ph, lds);
    if (ph + 1 < ph1) {
      if (ph1 < 0) grid.sync();
      xcd_barrier(xb);
    }
  }
}

extern "C" void kernel_launch(void* const* d_in, const int* in_sizes, int n_in, void* d_out, int out_size, void* d_ws, size_t ws_size,
                              hipStream_t stream) {
  if (ws_size < WS_NEED) { fprintf(stderr, "workspace too small: %zu < %zu\n", ws_size, (size_t)WS_NEED); return; }
  Params p{};
  const float** pp = (const float**)&p;
  for (int i = 0; i < 34; ++i) pp[i] = (const float*)d_in[i];
  p.out = (float*)d_out;
  p.ws = (char*)d_ws;
  static int grid_blocks = 0;
  if (!grid_blocks) {
    int dev = 0, cus = 0, per_cu = 0;
    hipGetDevice(&dev);
    hipDeviceGetAttribute(&cus, hipDeviceAttributeMultiprocessorCount, dev);
    hipOccupancyMaxActiveBlocksPerMultiprocessor(&per_cu, fwd_kernel, NTHR, 0);
    if (per_cu > 2) per_cu = 2;
    if (per_cu < 1) per_cu = 1;
    grid_blocks = cus * per_cu;
  }
  int ph0 = 0, ph1 = NPHASE;
  hipMemsetAsync((char*)d_ws + OFF_BAR, 0, SZ_BAR, stream);
  void* args[] = {&p, &ph0, &ph1};
  hipError_t e = hipLaunchCooperativeKernel((void*)fwd_kernel, dim3(grid_blocks), dim3(NTHR), args, 0, stream);
  if (e != hipSuccess) fprintf(stderr, "cooperative launch failed: %s (grid %d)\n", hipGetErrorString(e), grid_blocks);
}
```
